# Optimizing an MI355X kernel written in HIP

```python
import jax, jax.numpy as jnp
from jax import lax
import numpy as np

D_MODEL = 1024
BATCH = 16
SEQ = 4096
DEPTH = 4

CHUNK = 64
MEM_LEN = 256
HGRN_HEADS = 4
HGRN_HEAD_DIM = 128
HGRN_WIDTH = HGRN_HEADS * HGRN_HEAD_DIM
ATTN_HEADS = 8
ATTN_HEAD_DIM = 64
ATTN_WIDTH = ATTN_HEADS * ATTN_HEAD_DIM
LEFT_CHUNKS = 8
BAND = (LEFT_CHUNKS + 1) * CHUNK
MAX_REL = 128
N_REL = 2 * MAX_REL + 1
MIX_WIDTH = HGRN_WIDTH + ATTN_WIDTH
IN_WIDTH = 4 * HGRN_WIDTH + 3 * ATTN_WIDTH
MEM_HEADS = 4
MEM_HEAD_DIM = D_MODEL // MEM_HEADS
D_FF = 2816
N_EXPERTS = 8
TOP_K = 2
D_FF_EXPERT = 3584
MOE_BLOCK = 512
N_DENSE = (DEPTH + 1) // 2
N_MOE = DEPTH // 2
EPS = 1e-6

kernel_name = "hybrid_hgrn2_chunkattn_moe_encoder"


def rms_norm(x, gain):
    xf = x.astype(jnp.float32)
    y = xf * lax.rsqrt(jnp.mean(xf * xf, axis=-1, keepdims=True) + EPS)
    return (y * gain.astype(jnp.float32)).astype(x.dtype)


def hgrn2_mixer(q, f_logit, i_in, g, lower_bound, out_gain):
    B, S, _ = q.shape
    n_chunks = S // CHUNK
    lb = lower_bound.astype(jnp.float32)
    f = lb + (1.0 - lb) * jax.nn.sigmoid(f_logit.astype(jnp.float32))
    log_f = jnp.log(f)
    k = 1.0 - f

    def to_chunks(t):
        return t.reshape(B, n_chunks, CHUNK, HGRN_HEADS, HGRN_HEAD_DIM).transpose(1, 0, 3, 2, 4)

    causal = jnp.tril(jnp.ones((CHUNK, CHUNK), dtype=bool))

    def step(state, inp):
        qc, kc, vc, lfc = inp
        b = jnp.cumsum(lfc, axis=2)
        diff = b[:, :, :, None, :] - b[:, :, None, :, :]
        decay = jnp.exp(jnp.where(causal[None, None, :, :, None], diff, -jnp.inf))
        scores = jnp.einsum('bhtd,bhsd,bhtsd->bhts', qc, kc, decay)
        o = (jnp.einsum('bhts,bhse->bhte', scores, vc)
             + jnp.einsum('bhtd,bhde->bhte', qc * jnp.exp(b), state))
        b_end = b[:, :, -1, :]
        state = (jnp.exp(b_end)[..., None] * state
                 + jnp.einsum('bhsd,bhse->bhde', kc * jnp.exp(b_end[:, :, None, :] - b), vc))
        return state, o

    state0 = jnp.zeros((B, HGRN_HEADS, HGRN_HEAD_DIM, HGRN_HEAD_DIM), jnp.float32)
    _, o = lax.scan(step, state0, (to_chunks(q.astype(jnp.float32)), to_chunks(k),
                                   to_chunks(i_in.astype(jnp.float32)), to_chunks(log_f)))
    o = o.transpose(1, 0, 3, 2, 4).reshape(B, S, HGRN_HEADS, HGRN_HEAD_DIM)
    o = o * lax.rsqrt(jnp.mean(o * o, axis=-1, keepdims=True) + EPS)
    o = o.reshape(B, S, HGRN_WIDTH) * out_gain.astype(jnp.float32) * jax.nn.silu(g.astype(jnp.float32))
    return o.astype(q.dtype)


def chunk_attention(q, k, v, rel_bias, out_gain):
    B, S, _ = q.shape
    n_chunks = S // CHUNK
    scale = ATTN_HEAD_DIM ** -0.5
    qc_all = q.reshape(B, n_chunks, CHUNK, ATTN_HEADS, ATTN_HEAD_DIM).transpose(1, 0, 2, 3, 4)
    pad = ((0, 0), (LEFT_CHUNKS * CHUNK, 0), (0, 0), (0, 0))
    k_pad = jnp.pad(k.reshape(B, S, ATTN_HEADS, ATTN_HEAD_DIM), pad)
    v_pad = jnp.pad(v.reshape(B, S, ATTN_HEADS, ATTN_HEAD_DIM), pad)
    q_off = np.arange(CHUNK)[:, None] + LEFT_CHUNKS * CHUNK
    k_off = np.arange(BAND)[None, :]
    rel_idx = np.clip(q_off - k_off, -MAX_REL, MAX_REL) + MAX_REL
    bias = rel_bias[:, rel_idx].astype(jnp.float32)
    band_pos = jnp.arange(BAND)

    def one_chunk(args):
        qc, c = args
        kb = lax.dynamic_slice_in_dim(k_pad, c * CHUNK, BAND, axis=1)
        vb = lax.dynamic_slice_in_dim(v_pad, c * CHUNK, BAND, axis=1)
        s = jnp.einsum('bqhd,bkhd->bhqk', qc, kb).astype(jnp.float32) * scale + bias
        valid = band_pos >= (LEFT_CHUNKS - c) * CHUNK
        s = jnp.where(valid[None, None, None, :], s, -jnp.inf)
        p = jax.nn.softmax(s, axis=-1).astype(vb.dtype)
        return jnp.einsum('bhqk,bkhd->bqhd', p, vb)

    o = lax.map(one_chunk, (qc_all, jnp.arange(n_chunks)))
    o = o.transpose(1, 0, 2, 3, 4).reshape(B, S, ATTN_WIDTH)
    return rms_norm(o, out_gain)


def memory_cross_attention(h, mem_n, w_q, w_kv, w_o):
    B, S, _ = h.shape
    M = mem_n.shape[1]
    q = (h @ w_q).reshape(B, S, MEM_HEADS, MEM_HEAD_DIM)
    k, v = jnp.split(mem_n @ w_kv, 2, axis=-1)
    k = k.reshape(B, M, MEM_HEADS, MEM_HEAD_DIM)
    v = v.reshape(B, M, MEM_HEADS, MEM_HEAD_DIM)
    s = jnp.einsum('bshd,bmhd->bhsm', q, k).astype(jnp.float32) * (MEM_HEAD_DIM ** -0.5)
    p = jax.nn.softmax(s, axis=-1).astype(v.dtype)
    o = jnp.einsum('bhsm,bmhd->bshd', p, v).reshape(B, S, D_MODEL)
    return o @ w_o


def dense_swiglu(h, w_gate, w_up, w_down):
    return (jax.nn.silu(h @ w_gate) * (h @ w_up)) @ w_down


def moe_swiglu(h, w_router, w_gate, w_up, w_down):
    B, S, D = h.shape
    N = B * S
    hf = h.reshape(N, D)
    logits = (hf @ w_router).astype(jnp.float32)
    top_logits, top_idx = lax.top_k(logits, TOP_K)
    gates = jax.nn.softmax(top_logits, axis=-1)
    NK = N * TOP_K
    expert = top_idx.reshape(NK).astype(jnp.int32)
    token = jnp.repeat(jnp.arange(N, dtype=jnp.int32), TOP_K)
    gate = gates.reshape(NK)
    order = jnp.argsort(expert)
    expert_s, token_s, gate_s = expert[order], token[order], gate[order]
    counts = jnp.bincount(expert, length=N_EXPERTS)
    padded = (counts + MOE_BLOCK - 1) // MOE_BLOCK * MOE_BLOCK
    start = jnp.cumsum(counts) - counts
    padded_end = jnp.cumsum(padded)
    padded_start = padded_end - padded
    dest = padded_start[expert_s] + jnp.arange(NK, dtype=jnp.int32) - start[expert_s]
    n_blocks = -(-(NK + N_EXPERTS * (MOE_BLOCK - 1)) // MOE_BLOCK)
    P = n_blocks * MOE_BLOCK
    row_token = jnp.full((P,), N, jnp.int32).at[dest].set(token_s)
    row_gate = jnp.zeros((P,), jnp.float32).at[dest].set(gate_s)
    block_start = jnp.arange(n_blocks, dtype=jnp.int32) * MOE_BLOCK
    block_expert = jnp.minimum(jnp.searchsorted(padded_end, block_start, side='right'),
                               N_EXPERTS - 1).astype(jnp.int32)
    h_pad = jnp.concatenate([hf, jnp.zeros((1, D), hf.dtype)], axis=0)

    def expert_block(args):
        tok, e = args
        xb = h_pad[tok]
        return (jax.nn.silu(xb @ w_gate[e]) * (xb @ w_up[e])) @ w_down[e]

    yb = lax.map(expert_block, (row_token.reshape(n_blocks, MOE_BLOCK), block_expert))
    y = jnp.zeros((N + 1, D), jnp.float32).at[row_token].add(
        yb.reshape(P, D).astype(jnp.float32) * row_gate[:, None])
    return y[:N].reshape(B, S, D).astype(h.dtype)


def setup_inputs(seed: int = 0) -> dict:
    key = jax.random.key(seed)
    ks = jax.random.split(key, 32)
    f32 = jnp.float32

    def w(k, shape, fan_in):
        return jax.random.normal(k, shape, f32) * (fan_in ** -0.5)

    def gain(k, shape):
        return 1.0 + 0.02 * jax.random.normal(k, shape, f32)

    return {
        'x': jax.random.normal(ks[0], (BATCH, SEQ, D_MODEL), f32),
        'mem': jax.random.normal(ks[1], (BATCH, MEM_LEN, D_MODEL), f32),
        'w_in': w(ks[2], (DEPTH, D_MODEL, IN_WIDTH), D_MODEL),
        'hgrn_lower_bound': 0.1 * jax.random.normal(ks[3], (DEPTH, HGRN_WIDTH), f32),
        'hgrn_out_gain': gain(ks[4], (DEPTH, HGRN_WIDTH)),
        'attn_rel_bias': 0.2 * jax.random.normal(ks[5], (DEPTH, ATTN_HEADS, N_REL), f32),
        'attn_out_gain': gain(ks[6], (DEPTH, ATTN_WIDTH)),
        'w_out': w(ks[7], (DEPTH, MIX_WIDTH, D_MODEL), MIX_WIDTH),
        'norm_mix': gain(ks[8], (DEPTH, D_MODEL)),
        'norm_mem_q': gain(ks[9], (DEPTH, D_MODEL)),
        'norm_mem_kv': gain(ks[10], (DEPTH, D_MODEL)),
        'w_mem_q': w(ks[11], (DEPTH, D_MODEL, D_MODEL), D_MODEL),
        'w_mem_kv': w(ks[12], (DEPTH, D_MODEL, 2 * D_MODEL), D_MODEL),
        'w_mem_o': w(ks[13], (DEPTH, D_MODEL, D_MODEL), D_MODEL),
        'norm_ffn': gain(ks[14], (DEPTH, D_MODEL)),
        'w_ffn_gate': w(ks[15], (N_DENSE, D_MODEL, D_FF), D_MODEL),
        'w_ffn_up': w(ks[16], (N_DENSE, D_MODEL, D_FF), D_MODEL),
        'w_ffn_down': w(ks[17], (N_DENSE, D_FF, D_MODEL), D_FF),
        'w_router': w(ks[18], (N_MOE, D_MODEL, N_EXPERTS), D_MODEL),
        'w_exp_gate': w(ks[19], (N_MOE, N_EXPERTS, D_MODEL, D_FF_EXPERT), D_MODEL),
        'w_exp_up': w(ks[20], (N_MOE, N_EXPERTS, D_MODEL, D_FF_EXPERT), D_MODEL),
        'w_exp_down': w(ks[21], (N_MOE, N_EXPERTS, D_FF_EXPERT, D_MODEL), D_FF_EXPERT),
        'norm_final': gain(ks[22], (D_MODEL,)),
    }


def reference(x, mem, w_in, hgrn_lower_bound, hgrn_out_gain, attn_rel_bias, attn_out_gain,
              w_out, norm_mix, norm_mem_q, norm_mem_kv, w_mem_q, w_mem_kv, w_mem_o, norm_ffn,
              w_ffn_gate, w_ffn_up, w_ffn_down, w_router, w_exp_gate, w_exp_up, w_exp_down,
              norm_final):
    lb_probs = jax.nn.softmax(hgrn_lower_bound.astype(jnp.float32), axis=0)
    lower_bounds = jnp.cumsum(lb_probs, axis=0) - lb_probs[0]
    split_at = list(np.cumsum([HGRN_WIDTH] * 4 + [ATTN_WIDTH] * 2))
    h = x
    for layer in range(DEPTH):
        hn = rms_norm(h, norm_mix[layer])
        proj = hn @ w_in[layer]
        hq, hf_, hi, hg, aq, ak, av = jnp.split(proj, split_at, axis=-1)
        y_hgrn = hgrn2_mixer(hq, hf_, hi, hg, lower_bounds[layer], hgrn_out_gain[layer])
        y_attn = chunk_attention(aq, ak, av, attn_rel_bias[layer], attn_out_gain[layer])
        h = h + jnp.concatenate([y_hgrn, y_attn.astype(y_hgrn.dtype)], axis=-1) @ w_out[layer]
        hn = rms_norm(h, norm_mem_q[layer])
        mn = rms_norm(mem, norm_mem_kv[layer])
        h = h + memory_cross_attention(hn, mn, w_mem_q[layer], w_mem_kv[layer], w_mem_o[layer])
        hn = rms_norm(h, norm_ffn[layer])
        j = layer // 2
        if layer % 2 == 0:
            h = h + dense_swiglu(hn, w_ffn_gate[j], w_ffn_up[j], w_ffn_down[j])
        else:
            h = h + moe_swiglu(hn, w_router[j], w_exp_gate[j], w_exp_up[j], w_exp_down[j])
    return rms_norm(h, norm_final)
```

```cpp
#include <hip/hip_runtime.h>
#include <cstdio>
#include <cstdint>

namespace pg8 {
#define PG8_LAS __attribute__((address_space(3)))
typedef unsigned short bf16_t;
typedef short bf16x8 __attribute__((ext_vector_type(8)));
typedef float f32x4 __attribute__((ext_vector_type(4)));
typedef unsigned u32x4 __attribute__((ext_vector_type(4)));
constexpr int BM = 256, BK = 64, HALF = 128, HTB = HALF * BK * 2  , STAGE_BYTES = 8 * HTB, NXCD = 8, WGM = 8;

__host__ __device__ __forceinline__ int lds_byte(int r, int c) { const int st = (r >> 4) * 2 + (c >> 5), rr = r & 15, cc = c & 31, ob = rr * 64 + cc * 2; return st * 1024 + (ob ^ (((ob >> 9) & 1) << 5)); }
__host__ __device__ __forceinline__ void stage_rc(int b, int& R, int& C) { const int st = b / 1024, sb = b % 1024, swz = sb ^ (((sb >> 9) & 1) << 5); R = (st >> 1) * 16 + swz / 64; C = (st & 1) * 32 + (swz % 64) / 2; }
__host__ __device__ __forceinline__ int perm32(int rho) { const int n = rho >> 4, i = rho & 15; return 8 * (i >> 2) + 4 * n + (i & 3); }

struct Unit { int pm, pn; };
struct Gemm { const bf16_t* A; const bf16_t* Bt; int M, N, K; };

struct DenseOrder {
    int nM, nN, nwg, G, c; const char* A; const char* Bt; size_t a_t, b_t;
    __device__ __forceinline__ void init(int nM_, int nN_, int G_, int c_, const void* A_, const void* Bt_, int K) { nM = nM_; nN = nN_; nwg = nM * nN; G = G_; c = c_; A = (const char*)A_; Bt = (const char*)Bt_; a_t = (size_t)BM * K * 2; b_t = a_t; }
    __device__ __forceinline__ bool next(int i, Unit& u) const {
        const long L = (long)i * G + c; if (L >= nwg) return false;
        int wgid = (int)L; { const int q = nwg / NXCD, r = nwg % NXCD, xcd = wgid % NXCD, off = wgid / NXCD; wgid = (xcd < r ? xcd * (q + 1) : r * (q + 1) + (xcd - r) * q) + off; }
        const int nig = WGM * nN, gid = wgid / nig, fm = gid * WGM, gsz = (nM - fm) < WGM ? (nM - fm) : WGM;
        u.pm = fm + ((wgid % nig) % gsz); u.pn = (wgid % nig) / gsz; return true;
    }
    __device__ __forceinline__ const char* a_ptr(const Unit& u) const { return A + (size_t)u.pm * a_t; }
    __device__ __forceinline__ const char* b_ptr(const Unit& u) const { return Bt + (size_t)u.pn * b_t; }
    __device__ __forceinline__ void a_ready(const Unit&) const {}
    __device__ __forceinline__ void done(const Unit&) const {}
};
struct MoeOrder : DenseOrder {
    const PG8_LAS int* pexp; size_t e_stride;
    __device__ __forceinline__ const char* b_ptr(const Unit& u) const { return Bt + (size_t)pexp[u.pm] * e_stride + (size_t)u.pn * b_t; }
};

__device__ __forceinline__ unsigned cvt_pk_bf16(float lo, float hi) { unsigned r; asm volatile("v_cvt_pk_bf16_f32 %0, %1, %2" : "=v"(r) : "v"(lo), "v"(hi)); return r; }
constexpr float RMS_EPS = 1e-6f;
__device__ __forceinline__ float part_sum(const float* part, int r) {
    const f32x4* p = (const f32x4*)(part + (size_t)r * 16); const f32x4 a = p[0], b = p[1], c = p[2], d = p[3];
    return (((a[0] + a[1]) + (a[2] + a[3])) + ((b[0] + b[1]) + (b[2] + b[3]))) + (((c[0] + c[1]) + (c[2] + c[3])) + ((d[0] + d[1]) + (d[2] + d[3])));
}

struct EpiRowScale {
    static constexpr bool PERM = true, AFTER_DRAIN = false;
    bf16_t* O; int ldc; const float* ss;
    __device__ __forceinline__ void operator()(const f32x4 (&acc)[2][2][4][2], const Unit& u, int wr, int wc, int fr, int fq) const {
        const int row0 = u.pm * BM + wr * 64 + fr, col0 = u.pn * BM + wc * 32 + 8 * fq;
#pragma unroll
        for (int ai = 0; ai < 2; ++ai)
#pragma unroll
            for (int m = 0; m < 4; ++m) { const int r = row0 + ai * HALF + m * 16; const float s = 1.0f / sqrtf(part_sum(ss, r) * (1.0f / 1024.0f) + RMS_EPS);
                bf16_t* rowp = O + (size_t)r * ldc + col0;
#pragma unroll
                for (int bj = 0; bj < 2; ++bj) { const f32x4 v0 = acc[ai][bj][m][0] * s, v1 = acc[ai][bj][m][1] * s;
                    u32x4 w; w.x = cvt_pk_bf16(v0[0], v0[1]); w.y = cvt_pk_bf16(v0[2], v0[3]); w.z = cvt_pk_bf16(v1[0], v1[1]); w.w = cvt_pk_bf16(v1[2], v1[3]);
                    *(u32x4*)(rowp + bj * HALF) = w; } }
    }
};
struct EpiResid {
    static constexpr bool PERM = false, AFTER_DRAIN = false;
    const float* base; float* out; bf16_t* hb; float* ssn;
    __device__ __forceinline__ void operator()(const f32x4 (&acc)[2][2][4][2], const Unit& u, int wr, int wc, int fr, int fq) const {
        typedef unsigned u32x2v __attribute__((ext_vector_type(2)));
        const int row0 = u.pm * BM + wr * 64 + fr, col0 = u.pn * BM + wc * 32 + 4 * fq;
#pragma unroll
        for (int ai = 0; ai < 2; ++ai)
#pragma unroll
            for (int m = 0; m < 4; ++m) { const int r = row0 + ai * HALF + m * 16; const size_t off = (size_t)r * 1024 + col0; float q = 0.f;
#pragma unroll
                for (int bj = 0; bj < 2; ++bj)
#pragma unroll
                    for (int n = 0; n < 2; ++n) { const f32x4 bs = *(const f32x4*)(base + off + bj * HALF + n * 16); const f32x4 o = bs + acc[ai][bj][m][n];
                        *(f32x4*)(out + off + bj * HALF + n * 16) = o; q += (o[0] * o[0] + o[1] * o[1]) + (o[2] * o[2] + o[3] * o[3]);
                        u32x2v w; w.x = cvt_pk_bf16(o[0], o[1]); w.y = cvt_pk_bf16(o[2], o[3]); *(u32x2v*)(hb + off + bj * HALF + n * 16) = w; }
                q += __shfl_xor(q, 16); q += __shfl_xor(q, 32);
                if (fq == 0) ssn[(size_t)r * 16 + u.pn * 4 + wc] = q;
                asm volatile("" ::: "memory"); }
    }
};
template <bool RS_DIRECT> struct EpiSwiglu {
    static constexpr bool PERM = true, AFTER_DRAIN = false;
    bf16_t* O; int ldc; const float* ss;
    __device__ __forceinline__ void operator()(const f32x4 (&acc)[2][2][4][2], const Unit& u, int wr, int wc, int fr, int fq) const {
        const int row0 = u.pm * BM + wr * 64 + fr, col0 = u.pn * HALF + wc * 32 + 8 * fq;
#pragma unroll
        for (int ai = 0; ai < 2; ++ai)
#pragma unroll
            for (int m = 0; m < 4; ++m) { const int r = row0 + ai * HALF + m * 16; const float s = RS_DIRECT ? ss[r] : 1.0f / sqrtf(part_sum(ss, r) * (1.0f / 1024.0f) + RMS_EPS);
                float a[8];
#pragma unroll
                for (int n = 0; n < 2; ++n)
#pragma unroll
                    for (int j = 0; j < 4; ++j) { const float g = acc[ai][0][m][n][j] * s, up = acc[ai][1][m][n][j] * s;
                        a[n * 4 + j] = g * up * __builtin_amdgcn_rcpf(1.0f + __expf(-g)); }
                u32x4 w; w.x = cvt_pk_bf16(a[0], a[1]); w.y = cvt_pk_bf16(a[2], a[3]); w.z = cvt_pk_bf16(a[4], a[5]); w.w = cvt_pk_bf16(a[6], a[7]);
                *(u32x4*)(O + (size_t)r * ldc + col0) = w; }
    }
};
template <bool LAST> struct EpiMoeDown {
    static constexpr bool PERM = false, AFTER_DRAIN = false;
    float* h; bf16_t* hb; float* ssn; const int* row_tok; const float* row_gate;
    __device__ __forceinline__ void operator()(const f32x4 (&acc)[2][2][4][2], const Unit& u, int wr, int wc, int fr, int fq) const {
        typedef unsigned u32x2v __attribute__((ext_vector_type(2)));
        const int row0 = u.pm * BM + wr * 64 + fr, col0 = u.pn * BM + wc * 32 + 4 * fq;
#pragma unroll
        for (int ai = 0; ai < 2; ++ai)
#pragma unroll
            for (int m = 0; m < 4; ++m) { const int r = row0 + ai * HALF + m * 16; const int tok = row_tok[r]; const float gt = row_gate[r]; float q = 0.f;
                if (tok >= 0) { const size_t off = (size_t)tok * 1024 + col0;
#pragma unroll
                    for (int bj = 0; bj < 2; ++bj)
#pragma unroll
                        for (int n = 0; n < 2; ++n) { const f32x4 bs = *(const f32x4*)(h + off + bj * HALF + n * 16); const f32x4 o = bs + acc[ai][bj][m][n] * gt;
                            *(f32x4*)(h + off + bj * HALF + n * 16) = o;
                            if (LAST) { q += (o[0] * o[0] + o[1] * o[1]) + (o[2] * o[2] + o[3] * o[3]);
                                u32x2v w; w.x = cvt_pk_bf16(o[0], o[1]); w.y = cvt_pk_bf16(o[2], o[3]); *(u32x2v*)(hb + off + bj * HALF + n * 16) = w; } } }
                if (LAST) { q += __shfl_xor(q, 16); q += __shfl_xor(q, 32); if (fq == 0 && tok >= 0) ssn[(size_t)tok * 16 + u.pn * 4 + wc] = q; }
                asm volatile("" ::: "memory"); }
    }
};

template <class Epi, class Sched, bool ALIGN_EPI = false, bool SP2 = false>
__device__ __forceinline__ void gemm_phase(PG8_LAS unsigned char* lds, const int K, const Sched& S, const Epi& E) {
    int tid_o = threadIdx.x; asm volatile("" : "+v"(tid_o));
    const int tid = tid_o, wid = __builtin_amdgcn_readfirstlane(tid >> 6), lane = tid & 63, wr = wid >> 2, wc = wid & 3, fr = lane & 15, fq = lane >> 4;
    const int nt = K / BK;
    unsigned voffA[2], voffB[2];
#pragma unroll
    for (int i = 0; i < 2; ++i) { int R, C; stage_rc(tid * 16 + i * 8192, R, C); const int Rb = Epi::PERM ? ((R & ~31) + perm32(R & 31)) : R;
        voffA[i] = (unsigned)(R * K + C) * 2u; voffB[i] = (unsigned)(Rb * K + C) * 2u; }
    const size_t kstep = (size_t)(BK * 2);
    const size_t hstep = (size_t)HALF * K * 2;
    const size_t tstep = 2 * hstep;
    const unsigned ldsw = (unsigned)wid * 1024u;
    const int aoff = lds_byte(wr * 64 + fr, fq * 8), boff = lds_byte(wc * 32 + fr, fq * 8);
#define PG8_SA(b, h) (((b) * 2 + (h)) * HTB)
#define PG8_SB(b, h) ((4 + (b) * 2 + (h)) * HTB)
#define PG8_STAGE(bufoff, gbase, voff) do { _Pragma("unroll") for (int _i = 0; _i < 2; ++_i) \
        __builtin_amdgcn_global_load_lds((const unsigned*)((const char*)(gbase) + (voff)[_i]), (PG8_LAS unsigned*)(lds + (bufoff) + ldsw + _i * 8192), 16, 0, 0); } while (0)
#define PG8_LDA(dst, b, h) do { _Pragma("unroll") for (int m = 0; m < 4; ++m) _Pragma("unroll") for (int k = 0; k < 2; ++k) dst[m][k] = *(const PG8_LAS bf16x8*)(lds + PG8_SA(b, h) + aoff + m * 2048 + k * 1024); } while (0)
#define PG8_LDB(dst, b, h) do { _Pragma("unroll") for (int n = 0; n < 2; ++n) _Pragma("unroll") for (int k = 0; k < 2; ++k) dst[n][k] = *(const PG8_LAS bf16x8*)(lds + PG8_SB(b, h) + boff + n * 2048 + k * 1024); } while (0)
#define PG8_MMA(ai, bj, At, Bt) do { __builtin_amdgcn_s_setprio(1); _Pragma("unroll") for (int m = 0; m < 4; ++m) _Pragma("unroll") for (int n = 0; n < 2; ++n) _Pragma("unroll") for (int k = 0; k < 2; ++k) \
        acc[ai][bj][m][n] = __builtin_amdgcn_mfma_f32_16x16x32_bf16(Bt[n][k], At[m][k], acc[ai][bj][m][n], 0, 0, 0); __builtin_amdgcn_s_setprio(0); } while (0)
#define PG8_WAIT_V(n) asm volatile("s_waitcnt vmcnt(" #n ")" ::: "memory")
#define PG8_WAIT_L(n) asm volatile("s_waitcnt lgkmcnt(" #n ")" ::: "memory")
#define PG8_BAR __builtin_amdgcn_s_barrier()
#define PG8_SCHED __builtin_amdgcn_sched_barrier(0)
    Unit cur, nxt; int ui = 0;
    if (!S.next(0, cur)) return;
    f32x4 acc[2][2][4][2];
#pragma unroll
    for (int a = 0; a < 2; ++a)
#pragma unroll
        for (int b = 0; b < 2; ++b)
#pragma unroll
            for (int m = 0; m < 4; ++m)
#pragma unroll
                for (int n = 0; n < 2; ++n) acc[a][b][m][n] = (f32x4){0.f, 0.f, 0.f, 0.f};
    bf16x8 At[4][2], B0[2][2], B1[2][2];
    const char* cA = S.a_ptr(cur); const char* cB = S.b_ptr(cur);
    S.a_ready(cur);
    if constexpr (SP2) {
        PG8_STAGE(PG8_SB(0, 0), cB, voffB); PG8_STAGE(PG8_SB(0, 1), cB + hstep, voffB); PG8_STAGE(PG8_SA(0, 0), cA, voffA); PG8_STAGE(PG8_SA(0, 1), cA + hstep, voffA);
        if (wr == 1) PG8_BAR;
        PG8_WAIT_V(2); PG8_BAR;
        PG8_STAGE(PG8_SB(1, 0), cB + kstep, voffB); PG8_STAGE(PG8_SA(1, 0), cA + kstep, voffA); PG8_STAGE(PG8_SB(1, 1), cB + hstep + kstep, voffB);
        PG8_WAIT_V(6); PG8_BAR;
    } else {
        PG8_STAGE(PG8_SB(0, 0), cB, voffB); PG8_STAGE(PG8_SA(0, 0), cA, voffA); PG8_STAGE(PG8_SB(0, 1), cB + hstep, voffB); PG8_STAGE(PG8_SA(0, 1), cA + hstep, voffA);
        if (wr == 1) PG8_BAR;
        PG8_WAIT_V(4); PG8_BAR;
        PG8_STAGE(PG8_SB(1, 0), cB + kstep, voffB); PG8_STAGE(PG8_SA(1, 0), cA + kstep, voffA); PG8_STAGE(PG8_SB(1, 1), cB + hstep + kstep, voffB);
        PG8_WAIT_V(6); PG8_BAR;
    }
    for (;;) {
        const bool has_next = S.next(ui + 1, nxt);
        const char* nA = has_next ? S.a_ptr(nxt) : cA; const char* nB = has_next ? S.b_ptr(nxt) : cB;
        for (int t = 0; t < nt; t += 2) {
            const bool last = (t == nt - 2);
            const char* a1 = cA + (size_t)(t + 1) * kstep;
            const char* a2 = last ? nA : cA + (size_t)(t + 2) * kstep; const char* b2 = last ? nB : cB + (size_t)(t + 2) * kstep;
            const char* a3 = a2 + kstep; const char* b3 = b2 + kstep;
            if (last && has_next) S.a_ready(nxt);
            if constexpr (SP2) {
            PG8_LDB(B0, 0, 0); PG8_LDB(B1, 0, 1); PG8_SCHED; PG8_LDA(At, 0, 0); PG8_STAGE(PG8_SA(1, 1), a1 + hstep, voffA);
            PG8_WAIT_V(8); PG8_WAIT_L(0); PG8_BAR; PG8_MMA(0, 0, At, B0); PG8_MMA(0, 1, At, B1); PG8_BAR; PG8_SCHED;
            PG8_LDA(At, 0, 1); PG8_STAGE(PG8_SB(0, 0), b2, voffB); PG8_STAGE(PG8_SB(0, 1), b2 + hstep, voffB); PG8_STAGE(PG8_SA(0, 0), a2, voffA);
            PG8_WAIT_V(8); PG8_WAIT_L(0); PG8_BAR; PG8_MMA(1, 0, At, B0); PG8_MMA(1, 1, At, B1); PG8_BAR; PG8_SCHED;
            PG8_LDB(B0, 1, 0); PG8_LDB(B1, 1, 1); PG8_SCHED; PG8_LDA(At, 1, 0); PG8_STAGE(PG8_SA(0, 1), a2 + hstep, voffA);
            PG8_WAIT_V(8); PG8_WAIT_L(0); PG8_BAR; PG8_MMA(0, 0, At, B0); PG8_MMA(0, 1, At, B1); PG8_BAR; PG8_SCHED;
            PG8_LDA(At, 1, 1); PG8_STAGE(PG8_SB(1, 0), b3, voffB); PG8_STAGE(PG8_SB(1, 1), b3 + hstep, voffB); PG8_STAGE(PG8_SA(1, 0), a3, voffA);
            PG8_WAIT_V(8); PG8_WAIT_L(0); PG8_BAR; PG8_MMA(1, 0, At, B0); PG8_MMA(1, 1, At, B1); PG8_BAR; PG8_SCHED;
            } else {
            PG8_LDB(B0, 0, 0); PG8_SCHED; PG8_LDA(At, 0, 0); PG8_STAGE(PG8_SA(1, 1), a1 + hstep, voffA);
            PG8_WAIT_L(8); PG8_BAR; PG8_WAIT_L(0); PG8_MMA(0, 0, At, B0); PG8_BAR; PG8_SCHED;
            PG8_LDB(B1, 0, 1); PG8_STAGE(PG8_SB(0, 0), b2, voffB);
            PG8_BAR; PG8_WAIT_L(0); PG8_MMA(0, 1, At, B1); PG8_BAR;
            PG8_LDA(At, 0, 1); PG8_STAGE(PG8_SA(0, 0), a2, voffA);
            PG8_BAR; PG8_WAIT_L(0); PG8_MMA(1, 0, At, B0); PG8_BAR; PG8_SCHED;
            PG8_STAGE(PG8_SB(0, 1), b2 + hstep, voffB);
            PG8_WAIT_V(6); PG8_BAR; PG8_MMA(1, 1, At, B1); PG8_BAR;
            PG8_LDB(B0, 1, 0); PG8_SCHED; PG8_LDA(At, 1, 0); PG8_STAGE(PG8_SA(0, 1), a2 + hstep, voffA);
            PG8_WAIT_L(8); PG8_BAR; PG8_WAIT_L(0); PG8_MMA(0, 0, At, B0); PG8_BAR; PG8_SCHED;
            PG8_LDB(B1, 1, 1); PG8_STAGE(PG8_SB(1, 0), b3, voffB);
            PG8_BAR; PG8_WAIT_L(0); PG8_MMA(0, 1, At, B1); PG8_BAR;
            PG8_LDA(At, 1, 1); PG8_STAGE(PG8_SA(1, 0), a3, voffA);
            PG8_BAR; PG8_WAIT_L(0); PG8_MMA(1, 0, At, B0); PG8_BAR; PG8_SCHED;
            PG8_STAGE(PG8_SB(1, 1), b3 + hstep, voffB);
            PG8_WAIT_V(6); PG8_BAR; PG8_MMA(1, 1, At, B1); PG8_BAR;
            }
        }
        if constexpr (ALIGN_EPI) { if (wr == 0) PG8_BAR; }
        if constexpr (!Epi::AFTER_DRAIN) { E(acc, cur, wr, wc, fr, fq); S.done(cur); }
        if (!has_next) break;
#pragma unroll
        for (int a = 0; a < 2; ++a)
#pragma unroll
            for (int b = 0; b < 2; ++b)
#pragma unroll
                for (int m = 0; m < 4; ++m)
#pragma unroll
                    for (int n = 0; n < 2; ++n) acc[a][b][m][n] = (f32x4){0.f, 0.f, 0.f, 0.f};
        cur = nxt; cA = nA; cB = nB; ++ui;
        if constexpr (ALIGN_EPI) { if (wr == 1) PG8_BAR; }
    }
    PG8_WAIT_V(0);
    if constexpr (!ALIGN_EPI) { if (wr == 0) PG8_BAR; }
    PG8_BAR;
    if constexpr (Epi::AFTER_DRAIN) { E.fused(acc, cur, wr, wc, fr, fq, lds, wid, lane); S.done(cur); }
#undef PG8_SA
#undef PG8_SB
#undef PG8_STAGE
#undef PG8_LDA
#undef PG8_LDB
#undef PG8_MMA
#undef PG8_WAIT_V
#undef PG8_WAIT_L
#undef PG8_BAR
#undef PG8_SCHED
}
}

#define GAS __attribute__((address_space(1)))
#define LAS __attribute__((address_space(3)))
typedef unsigned short bf16;
typedef unsigned v4u __attribute__((ext_vector_type(4)));
typedef float f32x4 __attribute__((ext_vector_type(4)));
typedef short bf16x8 __attribute__((ext_vector_type(8)));
typedef GAS unsigned gu32;
typedef GAS unsigned long long gu64;
#define RLX_AGENT __ATOMIC_RELAXED, __HIP_MEMORY_SCOPE_AGENT
#define LDS_WAIT() asm volatile("s_waitcnt lgkmcnt(0)" ::: "memory")
#define VM_WAIT() asm volatile("s_waitcnt vmcnt(0)" ::: "memory")
__device__ __forceinline__ unsigned long long rt() { return __builtin_amdgcn_s_memrealtime(); }
__device__ __forceinline__ unsigned f2bf(float f) { unsigned u = __builtin_bit_cast(unsigned, f); return (u + 0x7fffu + ((u >> 16) & 1u)) >> 16; }
__device__ __forceinline__ unsigned pk2(float lo, float hi) { return f2bf(lo) | (f2bf(hi) << 16); }

#define XB_TMO      128
#define XB_XCNT(j)  (256  + 64 * (j))
#define XB_XSUB(j)  (1280 + 64 * (j))
#define XB_XGEN(j)  (2304 + 64 * (j))
#define XB_TOP      3328
#define XB_TOPGEN   3392
#define XCD_BAR_WORDS 3456
#define XB_SPIN_CAP (1u << 18)

__device__ __forceinline__ unsigned xb_ld(unsigned* p)              { return __hip_atomic_load(p, __ATOMIC_RELAXED, __HIP_MEMORY_SCOPE_AGENT); }
__device__ __forceinline__ unsigned xb_add(unsigned* p, unsigned v) { return __hip_atomic_fetch_add(p, v, __ATOMIC_RELAXED, __HIP_MEMORY_SCOPE_AGENT); }
__device__ __forceinline__ unsigned xb_xcc_id() { return (unsigned)__builtin_amdgcn_s_getreg((3 << 11) | 20) & 0xFu; }
#define XB_SPIN(cond, bar) do { unsigned _sp = 0; while (cond) { __builtin_amdgcn_s_sleep(1); \
    if ((++_sp & 255u) == 0u) { if (xb_ld(&(bar)[XB_TMO])) break; if (_sp > XB_SPIN_CAP) { atomicAdd(&(bar)[XB_TMO], 1u); break; } } } } while (0)

struct XcdBarrier {
    unsigned* bar; unsigned x;
    volatile LAS unsigned* st;
};

__device__ __forceinline__ XcdBarrier xcd_barrier_post(unsigned* bar, volatile LAS unsigned* st) {
    XcdBarrier b; b.bar = bar; b.x = xb_xcc_id(); b.st = st;
    if (threadIdx.x == 0) (void)xb_add(&bar[XB_XCNT(b.x)], 1u);
    return b;
}
__device__ __forceinline__ void xcd_barrier_complete(unsigned* bar, unsigned x, unsigned& nloc, unsigned& nx) {
    const unsigned G = gridDim.x * gridDim.y * gridDim.z;
    unsigned sum, cnt, mine, sp = 0u;
    for (;;) {
        sum = 0u; cnt = 0u; mine = 0u;
#pragma unroll
        for (unsigned j = 0; j < 16; ++j) { const unsigned c = xb_ld(&bar[XB_XCNT(j)]); sum += c; cnt += (c > 0u) ? 1u : 0u; mine = (j == x) ? c : mine; }
        if (sum == G) break;
        __builtin_amdgcn_s_sleep(1);
        if ((++sp & 255u) == 0u) { if (xb_ld(&bar[XB_TMO])) break; if (sp > XB_SPIN_CAP) { atomicAdd(&bar[XB_TMO], 1u); break; } }
    }
    nloc = mine > 0u ? mine : 1u; nx = cnt > 0u ? cnt : 1u;
}

__device__ __forceinline__ void xcd_barrier(const XcdBarrier& b) {
    asm volatile("s_waitcnt vmcnt(0)" ::: "memory");
    __syncthreads();
    if (threadIdx.x == 0) {
        unsigned* bar = b.bar;
        __builtin_amdgcn_s_waitcnt(0);
        unsigned nloc = b.st[0], nx = b.st[1];
        if (nloc == 0u) { xcd_barrier_complete(bar, b.x, nloc, nx); b.st[0] = nloc; b.st[1] = nx; }
        const unsigned old = xb_add(&bar[XB_XSUB(b.x)], 1u);
        const unsigned gen = old / nloc;
        if (old + 1u == (gen + 1u) * nloc) {
            __builtin_amdgcn_fence(__ATOMIC_RELEASE, "agent");
            asm volatile("s_waitcnt vmcnt(0)" ::: "memory");
            const unsigned og = xb_add(&bar[XB_TOP], 1u);
            const unsigned tg = og / nx;
            if (og + 1u == (tg + 1u) * nx) xb_add(&bar[XB_TOPGEN], 1u);
            else XB_SPIN(xb_ld(&bar[XB_TOPGEN]) == tg, bar);
            __builtin_amdgcn_fence(__ATOMIC_ACQUIRE, "agent");
            xb_add(&bar[XB_XGEN(b.x)], 1u);
            asm volatile("s_waitcnt vmcnt(0)" ::: "memory");
        } else {
            XB_SPIN(xb_ld(&bar[XB_XGEN(b.x)]) == gen, bar);
            __builtin_amdgcn_fence(__ATOMIC_ACQUIRE, "agent");
            asm volatile("s_waitcnt vmcnt(0)" ::: "memory");
        }
    }
    __syncthreads();
}

constexpr int NWAVES = 8;
constexpr int D = 1024, BATCH = 16, SEQ = 4096, DEPTH = 4, M = BATCH * SEQ;
constexpr int CHUNK = 64, NCHUNK = SEQ / CHUNK, MEM_LEN = 256, MROWS = BATCH * MEM_LEN;
constexpr int HG_H = 4, HG_D = 128, HG_W = 512, AT_H = 8, AT_D = 64, AT_W = 512, LEFTC = 8, MAXREL = 128, NREL = 257;
constexpr int INW = 3584;
constexpr int C_HQ = 0, C_HF = 512, C_HI = 1024, C_HGT = 1536, C_AQ = 2048, C_AK = 2560, C_AV = 3072;
constexpr int MH = 4, MHD = 256, FF = 2816, NE = 8, FFE = 3584;
constexpr int ROWS_PAD = M + NE * 256;
constexpr int MAXPANEL = ROWS_PAD / 256;
constexpr float EPS = 1e-6f;
enum { I_X = 0, I_MEM, I_WIN, I_LB, I_HGAIN, I_RELB, I_AGAIN, I_WOUT, I_NMIX, I_NMQ, I_NMKV, I_WMQ, I_WMKV, I_WMO, I_NFFN, I_WG, I_WU, I_WD, I_WR, I_EG, I_EU, I_ED, I_NFIN, N_IN };

constexpr size_t MiB = 1u << 20;
constexpr size_t WS_CTL = 0, CTL_ZERO_BYTES = 1 * MiB;
constexpr size_t WS_SS = 1 * MiB;
constexpr size_t WS_SSM = 5 * MiB;
constexpr size_t WS_RT = 8 * MiB;
constexpr size_t RT_TOKE = 0, RT_TOKG = 256 * 1024, RT_TOKRS = 768 * 1024, RT_ROWTOK = 1 * MiB, RT_ROWGATE = 1 * MiB + 768 * 1024, RT_ROWRS = 2 * MiB + 512 * 1024, RT_LB = 3 * MiB + 256 * 1024;
constexpr size_t WS_MB = 12 * MiB;
constexpr size_t WS_KV = 20 * MiB;
constexpr size_t WS_W = 84 * MiB;
constexpr size_t W_LAYER = 13 * MiB, W_IN = 0, W_OUT = 7 * MiB, W_MQ = 9 * MiB, W_MO = 11 * MiB;
constexpr size_t W_KV = 52 * MiB;
constexpr size_t W_FFN = 68 * MiB, W_FFN_STRIDE = 17 * MiB, W_FFN_GU = 0, W_FFN_D = 11 * MiB;
constexpr size_t WS_WM = 188 * MiB, WM_ESTRIDE = 21 * MiB, WM_GU = 0, WM_D = 14 * MiB;
constexpr size_t WS_HB = 356 * MiB;
constexpr size_t WS_MIX = 484 * MiB;
constexpr size_t WS_BIG = 616 * MiB;
constexpr size_t WS_END = 1078 * MiB;
static_assert(WS_W + W_FFN + 2 * W_FFN_STRIDE <= WS_WM && WS_WM + 8 * WM_ESTRIDE <= WS_HB && WS_MIX + (size_t)ROWS_PAD * D * 2 <= WS_BIG && WS_BIG + (size_t)ROWS_PAD * FFE * 2 <= WS_END, "ws map");
static_assert((size_t)5632 * 1024 * 2 <= W_FFN_D && W_FFN_D + (size_t)1024 * 2816 * 2 <= W_FFN_STRIDE && (size_t)7168 * 1024 * 2 <= WM_D && WM_D + (size_t)1024 * 3584 * 2 <= WM_ESTRIDE, "weight map");
constexpr int CW_TMO = 0, CW_CODE = 1, CW_BAR = 4096, CW_MOE = 16384;
constexpr int RING_BYTES = 131072, LDSCTL_OFF = RING_BYTES, MISC_OFF = LDSCTL_OFF + 320, PEXP_OFF = LDSCTL_OFF + 1024, LDS_BYTES = 147456;
static_assert(PEXP_OFF + MAXPANEL * 4 + 64 <= LDS_BYTES, "LDS map");

typedef unsigned u32x2 __attribute__((ext_vector_type(2)));
__device__ __forceinline__ float bf2f(unsigned short b) { return __uint_as_float(((unsigned)b) << 16); }
__device__ __forceinline__ float bflo(unsigned w) { return __uint_as_float(w << 16); }
__device__ __forceinline__ float bfhi(unsigned w) { return __uint_as_float(w & 0xffff0000u); }
__device__ __forceinline__ unsigned cvtpk(float lo, float hi) { return pg8::cvt_pk_bf16(lo, hi); }
__device__ __forceinline__ float wave_sum(float v) {
#pragma unroll
    for (int o = 1; o < 64; o <<= 1) v += __shfl_xor(v, o);
    return v;
}
__device__ __forceinline__ float wave_max(float v) {
#pragma unroll
    for (int o = 1; o < 64; o <<= 1) v = fmaxf(v, __shfl_xor(v, o));
    return v;
}
struct Args { const float* in[N_IN]; float* out; unsigned char* ws; int ph_lo, ph_hi; };

__device__ __forceinline__ void cvt_item(const float* W, int ldw, int K, const float* gain, bf16* WTrow, int k0, int n0, LAS float* scr, int lane) {
#pragma unroll 8
    for (int i = 0; i < 32; ++i) { const int kk = 2 * i + (lane >> 5); const float g = gain ? gain[k0 + kk] : 1.0f; scr[kk * 33 + (lane & 31)] = W[(size_t)(k0 + kk) * ldw + n0 + (lane & 31)] * g; }
    LDS_WAIT(); asm volatile("" ::: "memory");
    const int c = lane & 7;
#pragma unroll
    for (int j = 0; j < 4; ++j) { const int n = (lane >> 3) + 8 * j; const LAS float* s = scr + (8 * c) * 33 + n;
        v4u o; o.x = cvtpk(s[0 * 33], s[1 * 33]); o.y = cvtpk(s[2 * 33], s[3 * 33]); o.z = cvtpk(s[4 * 33], s[5 * 33]); o.w = cvtpk(s[6 * 33], s[7 * 33]);
        *(GAS v4u*)(WTrow + (size_t)n * K + k0 + 8 * c) = o; }
    LDS_WAIT(); asm volatile("" ::: "memory");
}
__device__ __forceinline__ void cvt_matrix(const float* W0, const float* W1, int K, int ldw, int NOUT, bf16* WT, const float* gain, LAS float* scr, int lane, int& rot, int gw, int ngw) {
    const int nblk = NOUT / 32, items = (K / 64) * nblk;
    int w0 = gw - rot; if (w0 < 0) w0 += ngw;
    for (int it = w0; it < items; it += ngw) {
        const int kb = it / nblk, nb = it - kb * nblk, R0 = nb * 32; const float* W = W0; int n0 = R0;
        if (W1) { const int tile = R0 >> 8, rr = R0 & 255; W = (rr < 128) ? W0 : W1; n0 = tile * 128 + (rr & 127); }
        cvt_item(W, ldw, K, gain, WT + (size_t)R0 * K, kb * 64, n0, scr, lane);
    }
    rot = (rot + items) % ngw;
}
__device__ __forceinline__ float row_to_bf16(const float* xrow, bf16* orow, int lane) {
    const GAS f32x4* xr = (const GAS f32x4*)xrow + lane; f32x4 v[4]; float s = 0.f;
#pragma unroll
    for (int j = 0; j < 4; ++j) { v[j] = xr[64 * j]; s += (v[j].x * v[j].x + v[j].y * v[j].y) + (v[j].z * v[j].z + v[j].w * v[j].w); }
    GAS u32x2* o8 = (GAS u32x2*)orow + lane;
#pragma unroll
    for (int j = 0; j < 4; ++j) { u32x2 w; w.x = cvtpk(v[j].x, v[j].y); w.y = cvtpk(v[j].z, v[j].w); o8[64 * j] = w; }
    return wave_sum(s);
}

__device__ __forceinline__ void naive_chunk_attn(const bf16* PROJ, bf16* MIX, const float* relb  , int w0, int nw, int lane) {
    for (int u = w0; u < BATCH * NCHUNK * AT_H; u += nw) {
        const int h = u & 7, c = (u >> 3) & 63, b = u >> 9;
        const size_t rowq = (size_t)b * SEQ + c * CHUNK + lane;
        float q[64], o[64];
        { const v4u* qp = (const v4u*)(PROJ + rowq * INW + C_AQ + h * AT_D);
#pragma unroll
          for (int d8 = 0; d8 < 8; ++d8) { const v4u w = qp[d8]; q[d8 * 8 + 0] = bflo(w.x) * 0.125f; q[d8 * 8 + 1] = bfhi(w.x) * 0.125f; q[d8 * 8 + 2] = bflo(w.y) * 0.125f; q[d8 * 8 + 3] = bfhi(w.y) * 0.125f;
              q[d8 * 8 + 4] = bflo(w.z) * 0.125f; q[d8 * 8 + 5] = bfhi(w.z) * 0.125f; q[d8 * 8 + 6] = bflo(w.w) * 0.125f; q[d8 * 8 + 7] = bfhi(w.w) * 0.125f; } }
#pragma unroll
        for (int d = 0; d < 64; ++d) o[d] = 0.f;
        float mx = -1e30f, l = 0.f;
        const int klo = (c > LEFTC ? c - LEFTC : 0) * CHUNK, khi = c * CHUNK + CHUNK, qpos = c * CHUNK + lane;
        const float* bh = relb + h * NREL;
        for (int kp = klo; kp < khi; ++kp) {
            const bf16* kr = PROJ + ((size_t)b * SEQ + kp) * INW + C_AK + h * AT_D;
            float s = 0.f;
#pragma unroll
            for (int d8 = 0; d8 < 8; ++d8) { const v4u w = ((const v4u*)kr)[d8];
                s += q[d8 * 8 + 0] * bflo(w.x) + q[d8 * 8 + 1] * bfhi(w.x) + q[d8 * 8 + 2] * bflo(w.y) + q[d8 * 8 + 3] * bfhi(w.y) + q[d8 * 8 + 4] * bflo(w.z) + q[d8 * 8 + 5] * bfhi(w.z) + q[d8 * 8 + 6] * bflo(w.w) + q[d8 * 8 + 7] * bfhi(w.w); }
            int rel = qpos - kp; rel = rel < -MAXREL ? -MAXREL : (rel > MAXREL ? MAXREL : rel);
            s += bh[rel + MAXREL];
            const float mn = fmaxf(mx, s), al = __expf(mx - mn), p = __expf(s - mn);
            l = l * al + p; mx = mn;
            const bf16* vr = kr + (C_AV - C_AK);
#pragma unroll
            for (int d8 = 0; d8 < 8; ++d8) { const v4u w = ((const v4u*)vr)[d8];
                o[d8 * 8 + 0] = o[d8 * 8 + 0] * al + p * bflo(w.x); o[d8 * 8 + 1] = o[d8 * 8 + 1] * al + p * bfhi(w.x); o[d8 * 8 + 2] = o[d8 * 8 + 2] * al + p * bflo(w.y); o[d8 * 8 + 3] = o[d8 * 8 + 3] * al + p * bfhi(w.y);
                o[d8 * 8 + 4] = o[d8 * 8 + 4] * al + p * bflo(w.z); o[d8 * 8 + 5] = o[d8 * 8 + 5] * al + p * bfhi(w.z); o[d8 * 8 + 6] = o[d8 * 8 + 6] * al + p * bflo(w.w); o[d8 * 8 + 7] = o[d8 * 8 + 7] * al + p * bfhi(w.w); }
        }
        const float il = 1.0f / l;
        v4u* op = (v4u*)(MIX + rowq * D + HG_W + h * AT_D);
#pragma unroll
        for (int d8 = 0; d8 < 8; ++d8) { v4u w; w.x = cvtpk(o[d8 * 8 + 0] * il, o[d8 * 8 + 1] * il); w.y = cvtpk(o[d8 * 8 + 2] * il, o[d8 * 8 + 3] * il); w.z = cvtpk(o[d8 * 8 + 4] * il, o[d8 * 8 + 5] * il); w.w = cvtpk(o[d8 * 8 + 6] * il, o[d8 * 8 + 7] * il); op[d8] = w; }
    }
}
__device__ __forceinline__ void naive_hgrn(const bf16* PROJ, bf16* MIX, const float* lb  , int bh, LAS float* L, int tid) {
    const int b = bh >> 2, h = bh & 3;
    LAS float* Lf = L; LAS float* Lk = L + 8192; LAS float* Lq = L + 16384; LAS float* Lv = L + 24576;
    float S[128];
#pragma unroll
    for (int d = 0; d < 128; ++d) S[d] = 0.f;
    for (int c = 0; c < NCHUNK; ++c) {
        __syncthreads();
#pragma unroll 4
        for (int i = 0; i < 16; ++i) { const int idx = tid + 512 * i, t = idx >> 7, d = idx & 127;
            const bf16* pr = PROJ + ((size_t)b * SEQ + c * CHUNK + t) * INW + h * HG_D + d;
            const float qv = bf2f(pr[C_HQ]), fl = bf2f(pr[C_HF]), iv = bf2f(pr[C_HI]); const float lbv = lb[h * HG_D + d];
            const float f = lbv + (1.0f - lbv) / (1.0f + __expf(-fl));
            Lf[idx] = f; Lk[idx] = 1.0f - f; Lq[idx] = qv; Lv[idx] = iv; }
        __syncthreads();
        if (tid < 128) {
            for (int t = 0; t < CHUNK; ++t) {
                const float v = Lv[t * 128 + tid]; float o = 0.f;
#pragma unroll
                for (int d = 0; d < 128; d += 4) { const f32x4 f4 = *(const LAS f32x4*)(Lf + t * 128 + d), k4 = *(const LAS f32x4*)(Lk + t * 128 + d), q4 = *(const LAS f32x4*)(Lq + t * 128 + d);
                    S[d + 0] = S[d + 0] * f4.x + k4.x * v; o += q4.x * S[d + 0]; S[d + 1] = S[d + 1] * f4.y + k4.y * v; o += q4.y * S[d + 1];
                    S[d + 2] = S[d + 2] * f4.z + k4.z * v; o += q4.z * S[d + 2]; S[d + 3] = S[d + 3] * f4.w + k4.w * v; o += q4.w * S[d + 3]; }
                MIX[((size_t)b * SEQ + c * CHUNK + t) * D + h * HG_D + tid] = (bf16)f2bf(o);
            }
        }
    }
    __syncthreads();
}
__device__ __forceinline__ void post_rows(const bf16* PROJ, bf16* MIX, const float* hgain, const float* again, int w0, int nw, int lane) {
    for (int r = w0; r < M; r += nw) {
        v4u* mp = (v4u*)(MIX + (size_t)r * D);
        { const v4u w = mp[lane]; float x[8] = {bflo(w.x), bfhi(w.x), bflo(w.y), bfhi(w.y), bflo(w.z), bfhi(w.z), bflo(w.w), bfhi(w.w)};
          float ss = 0.f;
#pragma unroll
          for (int j = 0; j < 8; ++j) ss += x[j] * x[j];
          ss += __shfl_xor(ss, 1); ss += __shfl_xor(ss, 2); ss += __shfl_xor(ss, 4); ss += __shfl_xor(ss, 8);
          const float rs = 1.0f / sqrtf(ss * (1.0f / 128.0f) + EPS);
          const v4u gw = *(const v4u*)(PROJ + (size_t)r * INW + C_HGT + lane * 8); const float g[8] = {bflo(gw.x), bfhi(gw.x), bflo(gw.y), bfhi(gw.y), bflo(gw.z), bfhi(gw.z), bflo(gw.w), bfhi(gw.w)};
          float y[8];
#pragma unroll
          for (int j = 0; j < 8; ++j) y[j] = x[j] * rs * hgain[lane * 8 + j] * g[j] / (1.0f + __expf(-g[j]));
          v4u o; o.x = cvtpk(y[0], y[1]); o.y = cvtpk(y[2], y[3]); o.z = cvtpk(y[4], y[5]); o.w = cvtpk(y[6], y[7]); mp[lane] = o; }
        { const v4u w = mp[64 + lane]; float x[8] = {bflo(w.x), bfhi(w.x), bflo(w.y), bfhi(w.y), bflo(w.z), bfhi(w.z), bflo(w.w), bfhi(w.w)};
          float ss = 0.f;
#pragma unroll
          for (int j = 0; j < 8; ++j) ss += x[j] * x[j];
          ss = wave_sum(ss); const float rs = 1.0f / sqrtf(ss * (1.0f / 512.0f) + EPS);
          float y[8];
#pragma unroll
          for (int j = 0; j < 8; ++j) y[j] = x[j] * rs * again[lane * 8 + j];
          v4u o; o.x = cvtpk(y[0], y[1]); o.y = cvtpk(y[2], y[3]); o.z = cvtpk(y[4], y[5]); o.w = cvtpk(y[6], y[7]); mp[64 + lane] = o; }
    }
}
__device__ __forceinline__ void naive_mem_attn(const bf16* Q, const bf16* KV, bf16* O, int layer, int w0, int nw, int lane) {
    for (int u = w0; u < BATCH * MH * SEQ; u += nw) {
        const int qi = u & (SEQ - 1), h = (u >> 12) & 3, b = u >> 14;
        const size_t row = (size_t)b * SEQ + qi;
        const bf16* Qp = Q + row * D + h * MHD;
        const bf16* Kb = KV + (size_t)b * MEM_LEN * (DEPTH * 2048) + layer * 2048 + h * MHD; const bf16* Vb = Kb + 1024;
        float s[4] = {0.f, 0.f, 0.f, 0.f};
#pragma unroll 4
        for (int d8 = 0; d8 < 32; ++d8) { const v4u qw = ((const v4u*)Qp)[d8]; const float qf[8] = {bflo(qw.x), bfhi(qw.x), bflo(qw.y), bfhi(qw.y), bflo(qw.z), bfhi(qw.z), bflo(qw.w), bfhi(qw.w)};
#pragma unroll
            for (int i = 0; i < 4; ++i) { const v4u kw = *(const v4u*)(Kb + (size_t)(lane + 64 * i) * (DEPTH * 2048) + d8 * 8);
                s[i] += qf[0] * bflo(kw.x) + qf[1] * bfhi(kw.x) + qf[2] * bflo(kw.y) + qf[3] * bfhi(kw.y) + qf[4] * bflo(kw.z) + qf[5] * bfhi(kw.z) + qf[6] * bflo(kw.w) + qf[7] * bfhi(kw.w); } }
        float mx = -1e30f;
#pragma unroll
        for (int i = 0; i < 4; ++i) { s[i] *= 0.0625f; mx = fmaxf(mx, s[i]); }
        mx = wave_max(mx); float p[4], sum = 0.f;
#pragma unroll
        for (int i = 0; i < 4; ++i) { p[i] = __expf(s[i] - mx); sum += p[i]; }
        sum = wave_sum(sum);
        float o0 = 0.f, o1 = 0.f, o2 = 0.f, o3 = 0.f;
#pragma unroll
        for (int i = 0; i < 4; ++i) {
#pragma unroll 8
            for (int kk = 0; kk < 64; ++kk) { const float pk = __shfl(p[i], kk); const u32x2 vw = *(const u32x2*)(Vb + (size_t)(kk + 64 * i) * (DEPTH * 2048) + lane * 4);
                o0 += pk * bflo(vw.x); o1 += pk * bfhi(vw.x); o2 += pk * bflo(vw.y); o3 += pk * bfhi(vw.y); } }
        const float il = 1.0f / sum; u32x2 w; w.x = cvtpk(o0 * il, o1 * il); w.y = cvtpk(o2 * il, o3 * il);
        *(u32x2*)(O + row * D + h * MHD + lane * 4) = w;
    }
}

__device__ __forceinline__ void route1(const float* H, const float* nffn, const float* wr, unsigned* toke, float* tokg, float* tokrs, gu32* cnt, LAS unsigned* lcnt, int w0, int nw, int lane, int tid) {
    if (tid < 16) lcnt[tid] = 0u;
    __syncthreads();
    for (int tok = w0; tok < M; tok += nw) {
        const GAS f32x4* hr = (const GAS f32x4*)(H + (size_t)tok * D) + lane;
        float a[8] = {0.f, 0.f, 0.f, 0.f, 0.f, 0.f, 0.f, 0.f}; float ss = 0.f;
#pragma unroll
        for (int j = 0; j < 4; ++j) { const f32x4 v = hr[64 * j]; const int k0 = (64 * j + lane) * 4; const f32x4 gn = *(const f32x4*)(nffn + k0);
#pragma unroll
            for (int jj = 0; jj < 4; ++jj) { const float x = v[jj]; ss += x * x; const float xg = x * gn[jj];
                const f32x4 w0v = *(const f32x4*)(wr + (size_t)(k0 + jj) * NE), w1v = *(const f32x4*)(wr + (size_t)(k0 + jj) * NE + 4);
                a[0] += xg * w0v.x; a[1] += xg * w0v.y; a[2] += xg * w0v.z; a[3] += xg * w0v.w; a[4] += xg * w1v.x; a[5] += xg * w1v.y; a[6] += xg * w1v.z; a[7] += xg * w1v.w; } }
        ss = wave_sum(ss);
#pragma unroll
        for (int e = 0; e < 8; ++e) a[e] = wave_sum(a[e]);
        const float rs = 1.0f / sqrtf(ss * (1.0f / 1024.0f) + EPS);
        int e1 = 0; float l1 = a[0];
#pragma unroll
        for (int e = 1; e < 8; ++e) if (a[e] > l1) { l1 = a[e]; e1 = e; }
        int e2 = -1; float l2 = -3.0e38f;
#pragma unroll
        for (int e = 0; e < 8; ++e) if (e != e1 && a[e] > l2) { l2 = a[e]; e2 = e; }
        const float g1 = 1.0f / (1.0f + __expf((l2 - l1) * rs)), g2 = 1.0f - g1;
        if (lane == 0) { toke[tok] = (unsigned)e1 | ((unsigned)e2 << 8); tokg[2 * tok] = g1; tokg[2 * tok + 1] = g2; tokrs[tok] = rs;
            __hip_atomic_fetch_add(lcnt + e1, 1u, __ATOMIC_RELAXED, __HIP_MEMORY_SCOPE_WORKGROUP); __hip_atomic_fetch_add(lcnt + 8 + e2, 1u, __ATOMIC_RELAXED, __HIP_MEMORY_SCOPE_WORKGROUP); }
    }
    __syncthreads();
    if (tid < 16) { const unsigned v = lcnt[tid]; if (v) __hip_atomic_fetch_add(cnt + tid, v, RLX_AGENT); }
}
__device__ __forceinline__ void route2(const unsigned* toke, const float* tokg, const float* tokrs, gu32* cnt, gu32* cur, int* row_tok, float* row_gate, float* row_rs, int w0, int nw, int lane) {
    unsigned pst[2][8];
#pragma unroll
    for (int k = 0; k < 2; ++k) { unsigned acc = 0u;
#pragma unroll
        for (int e = 0; e < 8; ++e) { pst[k][e] = acc; acc += ((__hip_atomic_load(cnt + k * 8 + e, RLX_AGENT) + 255u) >> 8) << 8; } }
    for (int base = w0 * 64; base < M; base += nw * 64) {
        const int tok = base + lane; const unsigned te = toke[tok]; const float rs = tokrs[tok];
#pragma unroll
        for (int k = 0; k < 2; ++k) { const int e = (int)((te >> (8 * k)) & 255u); unsigned row = 0u;
#pragma unroll
            for (int ee = 0; ee < 8; ++ee) { const unsigned long long mask = __ballot(e == ee);
                if (mask) { const int n = __popcll(mask), leader = __ffsll((long long)mask) - 1; unsigned b0 = 0u;
                    if (lane == leader) b0 = __hip_atomic_fetch_add(cur + k * 8 + ee, (unsigned)n, RLX_AGENT);
                    b0 = __shfl(b0, leader);
                    if (e == ee) row = pst[k][ee] + b0 + (unsigned)__popcll(mask & ((1ull << lane) - 1ull)); } }
            row_tok[(size_t)k * ROWS_PAD + row] = tok; row_gate[(size_t)k * ROWS_PAD + row] = tokg[2 * tok + k]; row_rs[(size_t)k * ROWS_PAD + row] = rs; }
    }
}
__device__ __forceinline__ int moe_panels(gu32* cntk, LAS int* pexp, int tid) {
    int pp = 0, ex = 0;
#pragma unroll
    for (int e = 0; e < 8; ++e) { const int n = (int)((__hip_atomic_load(cntk + e, RLX_AGENT) + 255u) >> 8); if (tid >= pp && tid < pp + n) ex = e; pp += n; }
    if (tid < pp && tid < MAXPANEL) pexp[tid] = ex;
    __syncthreads();
    return pp;
}

__global__ void __launch_bounds__(NWAVES * 64, 2) fwd(Args args) {
    extern __shared__ __attribute__((aligned(16))) unsigned char lds[];
    LAS unsigned char* L = (LAS unsigned char*)lds;
    volatile LAS unsigned* MISC = (volatile LAS unsigned*)(L + MISC_OFF);
    { const int t0 = threadIdx.x; for (int u = t0; u < (LDS_BYTES - LDSCTL_OFF) / 4; u += NWAVES * 64) ((LAS unsigned*)(L + LDSCTL_OFF))[u] = 0u; }
    __syncthreads();
    XcdBarrier bar = xcd_barrier_post((unsigned*)((gu32*)(args.ws + WS_CTL)) + CW_BAR, MISC + 8);
    const int lo = args.ph_lo, hi = args.ph_hi; int ph = 0;
#define PH_BEGIN if (ph >= lo && ph < hi) { int tid = threadIdx.x; asm volatile("" : "+v"(tid)); GAS unsigned char* wsg_ = (GAS unsigned char*)args.ws; asm volatile("" : "+s"(wsg_)); unsigned char* ws = (unsigned char*)wsg_; \
    int G = gridDim.x; asm volatile("" : "+s"(G)); const int bx = blockIdx.x, vcu = (G % 8 == 0) ? (bx % 8) * (G / 8) + bx / 8 : bx, ngw = G * NWAVES; (void)ngw; \
    const int lane = tid & 63, wave = __builtin_amdgcn_readfirstlane(tid >> 6), gw = vcu * NWAVES + wave; (void)lane; (void)gw; gu32* ctl = (gu32*)(ws + WS_CTL); (void)ctl;
#define PH_END   if (ph + 1 < hi) xcd_barrier(bar); } ++ph;
#define SS   ((float*)(ws + WS_SS))
#define SSM  ((float*)(ws + WS_SSM))
#define HB   ((bf16*)(ws + WS_HB))
#define MIX  ((bf16*)(ws + WS_MIX))
#define BIG  ((bf16*)(ws + WS_BIG))
#define MB   ((bf16*)(ws + WS_MB))
#define KV   ((bf16*)(ws + WS_KV))
#define OUT  (args.out)
#define LBT  ((float*)(ws + WS_RT + RT_LB))
#define WL   (ws + WS_W + (size_t)l * W_LAYER)
#define WF   (ws + WS_W + W_FFN + (size_t)(l >> 1) * W_FFN_STRIDE)

    PH_BEGIN
    {   LAS float* scr = (LAS float*)(L + wave * 16384); int rot = 0;
        for (int l = 0; l < DEPTH; ++l) {
            cvt_matrix(args.in[I_WIN] + (size_t)l * D * INW, nullptr, D, INW, INW, (bf16*)(WL + W_IN), args.in[I_NMIX] + l * D, scr, lane, rot, gw, ngw);
            cvt_matrix(args.in[I_WOUT] + (size_t)l * D * D, nullptr, D, D, D, (bf16*)(WL + W_OUT), nullptr, scr, lane, rot, gw, ngw);
            cvt_matrix(args.in[I_WMQ] + (size_t)l * D * D, nullptr, D, D, D, (bf16*)(WL + W_MQ), args.in[I_NMQ] + l * D, scr, lane, rot, gw, ngw);
            cvt_matrix(args.in[I_WMKV] + (size_t)l * D * 2048, nullptr, D, 2048, 2048, (bf16*)(ws + WS_W + W_KV) + (size_t)l * 2048 * D, args.in[I_NMKV] + l * D, scr, lane, rot, gw, ngw);
            cvt_matrix(args.in[I_WMO] + (size_t)l * D * D, nullptr, D, D, D, (bf16*)(WL + W_MO), nullptr, scr, lane, rot, gw, ngw); }
        for (int j = 0; j < 2; ++j) { unsigned char* wfj = ws + WS_W + W_FFN + (size_t)j * W_FFN_STRIDE;
            cvt_matrix(args.in[I_WG] + (size_t)j * D * FF, args.in[I_WU] + (size_t)j * D * FF, D, FF, 2 * FF, (bf16*)(wfj + W_FFN_GU), args.in[I_NFFN] + (2 * j) * D, scr, lane, rot, gw, ngw);
            cvt_matrix(args.in[I_WD] + (size_t)j * FF * D, nullptr, FF, D, D, (bf16*)(wfj + W_FFN_D), nullptr, scr, lane, rot, gw, ngw); }
        for (int r = gw; r < M; r += ngw) { const float s = row_to_bf16(args.in[I_X] + (size_t)r * D, HB + (size_t)r * D, lane); if (lane < 16) SS[(size_t)r * 16 + lane] = lane == 0 ? s : 0.f; }
        for (int r = gw; r < MROWS; r += ngw) { const float s = row_to_bf16(args.in[I_MEM] + (size_t)r * D, MB + (size_t)r * D, lane); if (lane < 16) SSM[(size_t)r * 16 + lane] = lane == 0 ? s : 0.f; }
        for (int i = gw * 64 + lane; i < HG_W; i += ngw * 64) { const float* lbp = args.in[I_LB] + i; const float a0 = lbp[0], a1 = lbp[512], a2 = lbp[1024], a3 = lbp[1536];
            const float mx = fmaxf(fmaxf(a0, a1), fmaxf(a2, a3)); const float e0 = __expf(a0 - mx), e1 = __expf(a1 - mx), e2 = __expf(a2 - mx), e3 = __expf(a3 - mx); const float inv = 1.0f / (e0 + e1 + e2 + e3);
            LBT[i] = 0.f; LBT[512 + i] = e1 * inv; LBT[1024 + i] = (e1 + e2) * inv; LBT[1536 + i] = (e1 + e2 + e3) * inv; }
    }
    PH_END

    PH_BEGIN
    {   pg8::DenseOrder S; S.init(MROWS / 256, DEPTH * 2048 / 256, G, bx, MB, ws + WS_W + W_KV, D);
        pg8::EpiRowScale E{KV, DEPTH * 2048, SSM};
        pg8::gemm_phase<pg8::EpiRowScale, pg8::DenseOrder, true, true>(L, D, S, E); }
    PH_END

    for (int l = 0; l < DEPTH; ++l) {
        PH_BEGIN
        {   pg8::DenseOrder S; S.init(M / 256, INW / 256, G, bx, HB, WL + W_IN, D);
            pg8::EpiRowScale E{BIG, INW, SS};
            pg8::gemm_phase<pg8::EpiRowScale, pg8::DenseOrder, true, true>(L, D, S, E); }
        PH_END
        PH_BEGIN
        {   if (G >= 128) {
                if (bx < 64) naive_hgrn(BIG, MIX, LBT + l * HG_W, bx, (LAS float*)L, tid);
                else naive_chunk_attn(BIG, MIX, args.in[I_RELB] + (size_t)l * AT_H * NREL, (bx - 64) * NWAVES + wave, (G - 64) * NWAVES, lane);
            } else {
                for (int bh = bx; bh < 64; bh += G) naive_hgrn(BIG, MIX, LBT + l * HG_W, bh, (LAS float*)L, tid);
                naive_chunk_attn(BIG, MIX, args.in[I_RELB] + (size_t)l * AT_H * NREL, bx * NWAVES + wave, G * NWAVES, lane);
            } }
        PH_END
        PH_BEGIN
        post_rows(BIG, MIX, args.in[I_HGAIN] + l * HG_W, args.in[I_AGAIN] + l * AT_W, gw, ngw, lane);
        PH_END
        PH_BEGIN
        {   pg8::DenseOrder S; S.init(M / 256, D / 256, G, bx, MIX, WL + W_OUT, D);
            pg8::EpiResid E{l == 0 ? args.in[I_X] : (const float*)OUT, OUT, HB, SS};
            pg8::gemm_phase<pg8::EpiResid, pg8::DenseOrder, true, true>(L, D, S, E); }
        PH_END
        PH_BEGIN
        {   pg8::DenseOrder S; S.init(M / 256, D / 256, G, bx, HB, WL + W_MQ, D);
            pg8::EpiRowScale E{BIG, D, SS};
            pg8::gemm_phase<pg8::EpiRowScale, pg8::DenseOrder, true, true>(L, D, S, E); }
        PH_END
        PH_BEGIN
        naive_mem_attn(BIG, KV, BIG + (size_t)M * D, l, gw, ngw, lane);
        PH_END
        PH_BEGIN
        {   pg8::DenseOrder S; S.init(M / 256, D / 256, G, bx, BIG + (size_t)M * D, WL + W_MO, D);
            pg8::EpiResid E{OUT, OUT, HB, SS};
            pg8::gemm_phase<pg8::EpiResid, pg8::DenseOrder, true, true>(L, D, S, E); }
        PH_END
        if ((l & 1) == 0) {
            PH_BEGIN
            {   pg8::DenseOrder S; S.init(M / 256, 2 * FF / 256, G, bx, HB, WF + W_FFN_GU, D);
                pg8::EpiSwiglu<false> E{BIG, FF, SS};
                pg8::gemm_phase<pg8::EpiSwiglu<false>, pg8::DenseOrder, true, true>(L, D, S, E); }
            PH_END
            PH_BEGIN
            {   pg8::DenseOrder S; S.init(M / 256, D / 256, G, bx, BIG, WF + W_FFN_D, FF);
                pg8::EpiResid E{OUT, OUT, HB, SS};
                pg8::gemm_phase<pg8::EpiResid, pg8::DenseOrder, true, true>(L, FF, S, E); }
            PH_END
        } else {
            const int j = l >> 1;
#define CNT      (ctl + CW_MOE + j * 64)
#define CUR      (CNT + 32)
#define TOKE     ((unsigned*)(ws + WS_RT + RT_TOKE))
#define TOKG     ((float*)(ws + WS_RT + RT_TOKG))
#define TOKRS    ((float*)(ws + WS_RT + RT_TOKRS))
#define ROW_TOK  ((int*)(ws + WS_RT + RT_ROWTOK))
#define ROW_GATE ((float*)(ws + WS_RT + RT_ROWGATE))
#define ROW_RS   ((float*)(ws + WS_RT + RT_ROWRS))
#define PEXP     ((LAS int*)(L + PEXP_OFF))
            PH_BEGIN
            {   route1(OUT, args.in[I_NFFN] + l * D, args.in[I_WR] + (size_t)j * D * NE, TOKE, TOKG, TOKRS, CNT, (LAS unsigned*)(L + LDSCTL_OFF), gw, ngw, lane, tid);
                for (int i = gw * 64 + lane; i < 2 * ROWS_PAD; i += ngw * 64) ROW_TOK[i] = -1;
                LAS float* scr = (LAS float*)(L + wave * 16384); int rot = 0;
                for (int e = 0; e < NE; ++e) { unsigned char* we = ws + WS_WM + (size_t)e * WM_ESTRIDE; const size_t eo = (size_t)(j * NE + e) * D * FFE;
                    cvt_matrix(args.in[I_EG] + eo, args.in[I_EU] + eo, D, FFE, 2 * FFE, (bf16*)(we + WM_GU), args.in[I_NFFN] + l * D, scr, lane, rot, gw, ngw);
                    cvt_matrix(args.in[I_ED] + eo, nullptr, FFE, D, D, (bf16*)(we + WM_D), nullptr, scr, lane, rot, gw, ngw); } }
            PH_END
            PH_BEGIN
            route2(TOKE, TOKG, TOKRS, CNT, CUR, ROW_TOK, ROW_GATE, ROW_RS, gw, ngw, lane);
            PH_END
            for (int k = 0; k < 2; ++k) {
                PH_BEGIN
                {   const int np = moe_panels(CNT + k * 8, PEXP, tid);
                    for (int r = gw; r < np * 256; r += ngw) { const int tok = ROW_TOK[(size_t)k * ROWS_PAD + r];
                        if (tok >= 0) { const v4u* src = (const v4u*)(HB + (size_t)tok * D); v4u* dst = (v4u*)(MIX + (size_t)r * D); dst[lane] = src[lane]; dst[64 + lane] = src[64 + lane]; } } }
                PH_END
                PH_BEGIN
                {   const int np = moe_panels(CNT + k * 8, PEXP, tid);
                    pg8::MoeOrder S; S.init(np, 2 * FFE / 256, G, bx, MIX, ws + WS_WM + WM_GU, D); S.pexp = PEXP; S.e_stride = WM_ESTRIDE;
                    pg8::EpiSwiglu<true> E{BIG, FFE, ROW_RS + (size_t)k * ROWS_PAD};
                    pg8::gemm_phase<pg8::EpiSwiglu<true>, pg8::MoeOrder, true, true>(L, D, S, E); }
                PH_END
                PH_BEGIN
                {   const int np = moe_panels(CNT + k * 8, PEXP, tid);
                    pg8::MoeOrder S; S.init(np, D / 256, G, bx, BIG, ws + WS_WM + WM_D, FFE); S.pexp = PEXP; S.e_stride = WM_ESTRIDE;
                    if (k == 0) { pg8::EpiMoeDown<false> E{OUT, HB, SS, ROW_TOK, ROW_GATE};
                        pg8::gemm_phase<pg8::EpiMoeDown<false>, pg8::MoeOrder, true, true>(L, FFE, S, E); }
                    else { pg8::EpiMoeDown<true> E{OUT, HB, SS, ROW_TOK + ROWS_PAD, ROW_GATE + ROWS_PAD};
                        pg8::gemm_phase<pg8::EpiMoeDown<true>, pg8::MoeOrder, true, true>(L, FFE, S, E); } }
                PH_END
            }
        }
    }
    PH_BEGIN
    {   const float* ssf = SS; const float* gn = args.in[I_NFIN];
        for (int r = gw; r < M; r += ngw) { GAS f32x4* xr = (GAS f32x4*)(OUT + (size_t)r * D) + lane; const float rs = 1.0f / sqrtf(pg8::part_sum(ssf, r) * (1.0f / 1024.0f) + EPS);
#pragma unroll
            for (int jj = 0; jj < 4; ++jj) { const f32x4 v = xr[64 * jj]; const f32x4 g4 = *(const f32x4*)(gn + (64 * jj + lane) * 4); xr[64 * jj] = v * rs * g4; } } }
    PH_END
#undef PH_BEGIN
#undef PH_END
}

#ifndef MK_PER_PHASE
#define MK_PER_PHASE 0
#endif
constexpr int N_PHASES = 2 + DEPTH * 7 + (DEPTH / 2) * 2 + (DEPTH / 2) * 8 + 1;
extern "C" void kernel_launch(void* const* d_in, const int* in_sizes, int n_in, void* d_out, int out_size, void* d_ws, size_t ws_size, hipStream_t stream) {
    static int grid = 0;
    if (grid == 0) {
        if (n_in != N_IN || in_sizes[0] != M * D || out_size != M * D || ws_size < WS_END) { fprintf(stderr, "kernel_launch: unexpected shapes / workspace (n_in %d, in0 %d, out %d, ws %zu, need %zu); nothing launched\n", n_in, n_in > 0 ? in_sizes[0] : -1, out_size, ws_size, (size_t)WS_END); grid = -1; return; }
        int dev = 0, cus = 0, per_cu = 0;
        if (hipGetDevice(&dev) != hipSuccess || hipDeviceGetAttribute(&cus, hipDeviceAttributeMultiprocessorCount, dev) != hipSuccess) { grid = -1; return; }
        if (hipFuncSetAttribute((const void*)fwd, hipFuncAttributeMaxDynamicSharedMemorySize, LDS_BYTES) != hipSuccess) { fprintf(stderr, "kernel_launch: hipFuncSetAttribute failed\n"); grid = -1; return; }
        if (hipOccupancyMaxActiveBlocksPerMultiprocessor(&per_cu, (const void*)fwd, NWAVES * 64, LDS_BYTES) != hipSuccess || per_cu < 1) fprintf(stderr, "kernel_launch: occupancy query reports %d workgroups per CU\n", per_cu);
        (void)hipGetLastError();
        grid = cus;
    }
    if (grid < 0) return;
    if (hipMemsetAsync((char*)d_ws + WS_CTL, 0, CTL_ZERO_BYTES, stream) != hipSuccess) { fprintf(stderr, "kernel_launch: memset failed\n"); return; }
    Args a{};
    for (int i = 0; i < N_IN; ++i) a.in[i] = (const float*)d_in[i];
    a.out = (float*)d_out; a.ws = (unsigned char*)d_ws;
#if MK_PER_PHASE
    for (int p = 0; p < N_PHASES; ++p) { a.ph_lo = p; a.ph_hi = p + 1; hipLaunchKernelGGL(fwd, dim3(grid), dim3(NWAVES * 64), LDS_BYTES, stream, a); }
#else
    a.ph_lo = 0; a.ph_hi = N_PHASES;
    hipLaunchKernelGGL(fwd, dim3(grid), dim3(NWAVES * 64), LDS_BYTES, stream, a);
#endif
    const hipError_t le = hipPeekAtLastError();
    if (le != hipSuccess) fprintf(stderr, "kernel_launch: launch failed: %s\n", hipGetErrorName(le));
}
```

```cpp
#include <hip/hip_runtime.h>
#include <cstdio>
#include <cstdint>

namespace pg8 {
#define PG8_LAS __attribute__((address_space(3)))
typedef unsigned short bf16_t;
typedef short bf16x8 __attribute__((ext_vector_type(8)));
typedef float f32x4 __attribute__((ext_vector_type(4)));
typedef unsigned u32x4 __attribute__((ext_vector_type(4)));
constexpr int BM = 256, BK = 64, HALF = 128, HTB = HALF * BK * 2  , STAGE_BYTES = 8 * HTB, NXCD = 8, WGM = 8;

__host__ __device__ __forceinline__ int lds_byte(int r, int c) { const int st = (r >> 4) * 2 + (c >> 5), rr = r & 15, cc = c & 31, ob = rr * 64 + cc * 2; return st * 1024 + (ob ^ (((ob >> 9) & 1) << 5)); }
__host__ __device__ __forceinline__ void stage_rc(int b, int& R, int& C) { const int st = b / 1024, sb = b % 1024, swz = sb ^ (((sb >> 9) & 1) << 5); R = (st >> 1) * 16 + swz / 64; C = (st & 1) * 32 + (swz % 64) / 2; }
__host__ __device__ __forceinline__ int perm32(int rho) { const int n = rho >> 4, i = rho & 15; return 8 * (i >> 2) + 4 * n + (i & 3); }

struct Unit { int pm, pn; };
struct Gemm { const bf16_t* A; const bf16_t* Bt; int M, N, K; };

struct DenseOrder {
    static constexpr bool GATHER = false, A_HL = false, FP8 = false;
    __device__ __forceinline__ int a_row(const Unit&, int) const { return 0; }
    int nM, nN, nwg, G, c, wgm; const char* A; const char* Bt; size_t a_t, b_t;
    __device__ __forceinline__ void init(int nM_, int nN_, int G_, int c_, const void* A_, const void* Bt_, int K, int wgm_ = 4) { nM = nM_; nN = nN_; nwg = nM * nN; G = G_; c = c_; wgm = wgm_; A = (const char*)A_; Bt = (const char*)Bt_; a_t = (size_t)BM * K * 2; b_t = a_t; }
    __device__ __forceinline__ bool next(int i, Unit& u) const { return next_l((long)i * G + c, u); }
    __device__ __forceinline__ bool next_l(const long L, Unit& u) const {
        if (L >= nwg) return false;
        int wgid = (int)L; { const int q = nwg / NXCD, r = nwg % NXCD, xcd = wgid % NXCD, off = wgid / NXCD; wgid = (xcd < r ? xcd * (q + 1) : r * (q + 1) + (xcd - r) * q) + off; }
        const int nig = wgm * nN, gid = wgid / nig, fm = gid * wgm, gsz = (nM - fm) < wgm ? (nM - fm) : wgm;
        u.pm = fm + ((wgid % nig) % gsz); u.pn = (wgid % nig) / gsz; return true;
    }
    __device__ __forceinline__ const char* a_ptr(const Unit& u) const { return A + (size_t)u.pm * a_t; }
    __device__ __forceinline__ const char* b_ptr(const Unit& u) const { return Bt + (size_t)u.pn * b_t; }
    __device__ __forceinline__ void a_ready(const Unit&) const {}
    __device__ __forceinline__ void done(const Unit&) const {}
};
struct DenseOrder8 : DenseOrder { static constexpr bool FP8 = true; };
struct MoeOrder : DenseOrder {
    static constexpr bool FP8 = true;
    const PG8_LAS int* pexp; size_t e_stride;
    __device__ __forceinline__ const char* b_ptr(const Unit& u) const { return Bt + (size_t)pexp[u.pm] * e_stride + (size_t)u.pn * b_t; }
};

struct DenseOrderHL : DenseOrder {
    static constexpr bool A_HL = true;
    __device__ __forceinline__ void init(int nM_, int nN_, int G_, int c_, const void* A_, const void* Bt_, int K, int wgm_ = 4) { DenseOrder::init(nM_, nN_, G_, c_, A_, Bt_, K, wgm_); a_t = (size_t)BM * 4096; }
};
struct MoeGatherOrder : MoeOrder {
    static constexpr bool GATHER = true, A_HL = false;
    const int* row_tok;
    __device__ __forceinline__ const char* a_ptr(const Unit&) const { return A; }
    __device__ __forceinline__ int a_row(const Unit& u, int R) const { const int t = row_tok[u.pm * BM + R]; return t < 0 ? 0 : t; }
};

struct MoeGatherOrderSkew : MoeGatherOrder {
    int nheavy, skip;
    __device__ __forceinline__ bool next(int i, Unit& u) const {
        const long nl = G - nheavy; long L;
        if (c < nheavy) L = (long)skip * nl + (long)i * G + c;
        else if (i < skip) L = (long)i * nl + (c - nheavy);
        else L = (long)skip * nl + (long)(i - skip) * G + c;
        return next_l(L, u);
    }
};

__device__ __forceinline__ unsigned cvt_pk_bf16(float lo, float hi) { unsigned r; asm volatile("v_cvt_pk_bf16_f32 %0, %1, %2" : "=v"(r) : "v"(lo), "v"(hi)); return r; }
constexpr float RMS_EPS = 1e-6f;
__device__ __forceinline__ float sum_x32(float x) { const auto rr = __builtin_amdgcn_permlane32_swap(__float_as_uint(x), __float_as_uint(x), false, false); return __uint_as_float(rr[0]) + __uint_as_float(rr[1]); }
__device__ __forceinline__ float sum_x16(float x) { const auto rr = __builtin_amdgcn_permlane16_swap(__float_as_uint(x), __float_as_uint(x), false, false); return __uint_as_float(rr[0]) + __uint_as_float(rr[1]); }
__device__ __forceinline__ float max_x32(float x) { const auto rr = __builtin_amdgcn_permlane32_swap(__float_as_uint(x), __float_as_uint(x), false, false); return fmaxf(__uint_as_float(rr[0]), __uint_as_float(rr[1])); }
__device__ __forceinline__ float max_x16(float x) { const auto rr = __builtin_amdgcn_permlane16_swap(__float_as_uint(x), __float_as_uint(x), false, false); return fmaxf(__uint_as_float(rr[0]), __uint_as_float(rr[1])); }
template <int CTRL> __device__ __forceinline__ float dpp_f(float x) { return __uint_as_float((unsigned)__builtin_amdgcn_update_dpp(0, (int)__float_as_uint(x), CTRL, 0xf, 0xf, true)); }
__device__ __forceinline__ float row_sum16(float x) { x += dpp_f<0xB1>(x); x += dpp_f<0x4E>(x); x += dpp_f<0x124>(x); x += dpp_f<0x128>(x); return x; }
__device__ __forceinline__ float row_max16(float x) { x = fmaxf(x, dpp_f<0xB1>(x)); x = fmaxf(x, dpp_f<0x4E>(x)); x = fmaxf(x, dpp_f<0x124>(x)); x = fmaxf(x, dpp_f<0x128>(x)); return x; }
__device__ __forceinline__ float part_sum(const float* part, int r) {
    const f32x4* p = (const f32x4*)(part + (size_t)r * 16); const f32x4 a = p[0], b = p[1], c = p[2], d = p[3];
    return (((a[0] + a[1]) + (a[2] + a[3])) + ((b[0] + b[1]) + (b[2] + b[3]))) + (((c[0] + c[1]) + (c[2] + c[3])) + ((d[0] + d[1]) + (d[2] + d[3])));
}

__device__ __forceinline__ void row_rstd8(const float* ss, int row0, int fq, float (&rs)[2][4]) {
    f32x4 p[2][4];
#pragma unroll
    for (int ai = 0; ai < 2; ++ai)
#pragma unroll
        for (int m = 0; m < 4; ++m) p[ai][m] = *(const f32x4*)(ss + (size_t)(row0 + ai * HALF + m * 16) * 16 + 4 * fq);
#pragma unroll
    for (int ai = 0; ai < 2; ++ai)
#pragma unroll
        for (int m = 0; m < 4; ++m) { const float s = sum_x32(sum_x16((p[ai][m][0] + p[ai][m][1]) + (p[ai][m][2] + p[ai][m][3]))); rs[ai][m] = 1.0f / sqrtf(s * (1.0f / 1024.0f) + RMS_EPS); }
}
constexpr float F8_WGU = 32.0f, F8_WD = 64.0f, F8_ACT = 16.0f, F8_O = 32.0f, F8_WMO = 32.0f, F8_Q = 4.0f, F8_K = 4.0f;
__device__ __forceinline__ unsigned pk_fp8x4(float a, float b, float c, float d) {
    a = __builtin_amdgcn_fmed3f(a, -448.0f, 448.0f); b = __builtin_amdgcn_fmed3f(b, -448.0f, 448.0f); c = __builtin_amdgcn_fmed3f(c, -448.0f, 448.0f); d = __builtin_amdgcn_fmed3f(d, -448.0f, 448.0f);
    int p = __builtin_amdgcn_cvt_pk_fp8_f32(a, b, 0, false); p = __builtin_amdgcn_cvt_pk_fp8_f32(c, d, p, true); return (unsigned)p;
}
struct EpiRowScale {
    static constexpr int PID = 1;
    static constexpr bool PERM = true, AFTER_DRAIN = false;
    bf16_t* O; int ldc; const float* ss; float sc; int mode;
    __device__ __forceinline__ void operator()(const f32x4 (&acc)[2][2][4][2], const Unit& u, int wr, int wc, int fr, int fq) const {
        const int row0 = u.pm * BM + wr * 64 + fr, col0 = u.pn * BM + wc * 32 + 8 * fq;
        float rs[2][4]; row_rstd8(ss, row0, fq, rs);
#pragma unroll
        for (int ai = 0; ai < 2; ++ai)
#pragma unroll
            for (int m = 0; m < 4; ++m) { const int r = row0 + ai * HALF + m * 16; const float s = rs[ai][m] * sc;
                bf16_t* rowp = O + (size_t)r * ldc + col0;
                const bool k8 = mode == 2 && (u.pn & 7) < 4;
                if (mode == 1 || k8) { typedef unsigned u32x2_ __attribute__((ext_vector_type(2)));
                    unsigned char* rp8 = mode == 1 ? (unsigned char*)O + (size_t)r * ldc + col0 : (unsigned char*)O + (size_t)r * ldc * 2 + (u.pn >> 3) * 4096 + (u.pn & 3) * BM + wc * 32 + 8 * fq;
                    const float s8 = mode == 1 ? s : s * F8_K;
#pragma unroll
                    for (int bj = 0; bj < 2; ++bj) { const f32x4 v0 = acc[ai][bj][m][0] * s8, v1 = acc[ai][bj][m][1] * s8;
                        u32x2_ w; w.x = pk_fp8x4(v0[0], v0[1], v0[2], v0[3]); w.y = pk_fp8x4(v1[0], v1[1], v1[2], v1[3]); *(u32x2_*)(rp8 + bj * HALF) = w; }
                } else {
#pragma unroll
                for (int bj = 0; bj < 2; ++bj) { const f32x4 v0 = acc[ai][bj][m][0] * s, v1 = acc[ai][bj][m][1] * s;
                    u32x4 w; w.x = cvt_pk_bf16(v0[0], v0[1]); w.y = cvt_pk_bf16(v0[2], v0[3]); w.z = cvt_pk_bf16(v1[0], v1[1]); w.w = cvt_pk_bf16(v1[2], v1[3]);
                    *(u32x4*)(rowp + bj * HALF) = w; } } }
    }
};
struct EpiInProj {
    static constexpr int PID = 5;
    static constexpr bool PERM = true, AFTER_DRAIN = false;
    bf16_t* O; int ldc; const float* ss; const float* lb; float* gv; const float* hgain;
    __device__ __forceinline__ void operator()(const f32x4 (&acc_)[2][2][4][2], const Unit& u, int wr, int wc, int fr_, int fq_) const {
        f32x4 (&acc)[2][2][4][2] = const_cast<f32x4 (&)[2][2][4][2]>(acc_);
        int fr = fr_, fq = fq_; asm volatile("" : "+v"(fr), "+v"(fq));
        const int row0 = u.pm * BM + wr * 64 + fr, col0 = u.pn * BM + wc * 32 + 8 * fq;
        const float L2E = 1.4426950408889634f;
        float rs8[2][4]; row_rstd8(ss, row0, fq, rs8);
#pragma unroll
        for (int ai = 0; ai < 2; ++ai) {
            float rs[4];
#pragma unroll
            for (int m = 0; m < 4; ++m) rs[m] = rs8[ai][m];
            if (u.pn < 4) {
                const int d0 = wc * 32 + 8 * fq, chunk = u.pm * 4 + ai * 2 + wr;
#pragma unroll
                for (int n = 0; n < 2; ++n) { const f32x4 lb4 = *(const f32x4*)(lb + u.pn * 128 + d0 + 4 * n);
#pragma unroll
                    for (int j = 0; j < 4; ++j) { const float lbv = lb4[j]; float bb[4]; float pre = 0.f, bm = 0.f;
#pragma unroll
                        for (int m = 0; m < 4; ++m) { const float x = acc[ai][1][m][n][j] * rs[m]; const float f = lbv + (1.0f - lbv) * __builtin_amdgcn_rcpf(1.0f + __builtin_amdgcn_exp2f(-L2E * x));
                            float l2 = __builtin_amdgcn_logf(f); asm volatile("" : "+v"(l2));     acc[ai][1][m][n][j] = 1.0f - f;
                            float s = l2; s += dpp_f<0x111>(s); s += dpp_f<0x112>(s); s += dpp_f<0x114>(s); s += dpp_f<0x118>(s);
                            bb[m] = pre + s; pre += row_sum16(l2); if (m == 1) bm = pre; }
                        const float be = pre;
#pragma unroll
                        for (int m = 0; m < 4; ++m) { const float dd = bb[m] - bm; acc[ai][0][m][n][j] = acc[ai][0][m][n][j] * rs[m] * __builtin_amdgcn_exp2f(dd); acc[ai][1][m][n][j] *= __builtin_amdgcn_exp2f(-dd); }
                        if (fr == 0) { float* gp = gv + (size_t)chunk * 1536 + u.pn * 128 + d0 + 4 * n + j; gp[0] = __builtin_amdgcn_exp2f(be); gp[512] = __builtin_amdgcn_exp2f(be - bm); gp[1024] = __builtin_amdgcn_exp2f(bm); }
                        __builtin_amdgcn_sched_barrier(0); }
                }
#pragma unroll
                for (int m = 0; m < 4; ++m) rs[m] = 1.0f;
            }
#pragma unroll
            for (int m = 0; m < 4; ++m) { bf16_t* rowp = O + (size_t)(row0 + ai * HALF + m * 16) * ldc + col0; const float s = rs[m];
#pragma unroll
                for (int bj = 0; bj < 2; ++bj) { f32x4 v0 = acc[ai][bj][m][0] * s, v1 = acc[ai][bj][m][1] * s;
                    if (u.pn == 6 || u.pn == 7) {
                        const float* gq = hgain + (u.pn - 6) * BM + bj * HALF + wc * 32 + 8 * fq; const f32x4 ga = *(const f32x4*)gq, gb = *(const f32x4*)(gq + 4);
#pragma unroll
                        for (int j = 0; j < 4; ++j) { v0[j] = v0[j] * ga[j] * __builtin_amdgcn_rcpf(1.0f + __builtin_amdgcn_exp2f(-L2E * v0[j])); v1[j] = v1[j] * gb[j] * __builtin_amdgcn_rcpf(1.0f + __builtin_amdgcn_exp2f(-L2E * v1[j])); } }
                    u32x4 w; w.x = cvt_pk_bf16(v0[0], v0[1]); w.y = cvt_pk_bf16(v0[2], v0[3]); w.z = cvt_pk_bf16(v1[0], v1[1]); w.w = cvt_pk_bf16(v1[2], v1[3]);
                    *(u32x4*)(rowp + bj * HALF) = w; } }
            asm volatile("" ::: "memory"); __builtin_amdgcn_sched_barrier(0);
        }
    }
};
__device__ __forceinline__ void hl_load8(const unsigned char* p, float (&h)[8]) {
    const u32x4 a = *(const u32x4*)p;
    h[0] = __uint_as_float(a.x << 16); h[1] = __uint_as_float(a.x & 0xffff0000u); h[2] = __uint_as_float(a.y << 16); h[3] = __uint_as_float(a.y & 0xffff0000u);
    h[4] = __uint_as_float(a.z << 16); h[5] = __uint_as_float(a.z & 0xffff0000u); h[6] = __uint_as_float(a.w << 16); h[7] = __uint_as_float(a.w & 0xffff0000u);
}
__device__ __forceinline__ void hl_store8(unsigned char* p, const float (&h)[8]) {
    u32x4 a; a.x = cvt_pk_bf16(h[0], h[1]); a.y = cvt_pk_bf16(h[2], h[3]); a.z = cvt_pk_bf16(h[4], h[5]); a.w = cvt_pk_bf16(h[6], h[7]);
    *(u32x4*)p = a;
}
struct EpiResid {
    static constexpr int PID = 2;
    static constexpr bool PERM = true, AFTER_DRAIN = false;
    const unsigned char* base; unsigned char* out; float* ssn; unsigned char* xq; float sc;
    __device__ __forceinline__ void operator()(const f32x4 (&acc)[2][2][4][2], const Unit& u, int wr, int wc, int fr_, int fq_) const {
        (void)fr_; (void)fq_; unsigned z_ = 0u; asm volatile("" : "+s"(z_)); const int ln_ = (int)__builtin_amdgcn_mbcnt_hi(~0u, __builtin_amdgcn_mbcnt_lo(~0u, z_)), fr = ln_ & 15, fq = ln_ >> 4;
        const int row0 = u.pm * BM + wr * 64 + fr, g0 = u.pn * 32 + wc * 4 + fq;
        u32x4 ra[2][4][2];
#pragma unroll
        for (int ai = 0; ai < 2; ++ai)
#pragma unroll
            for (int m = 0; m < 4; ++m)
#pragma unroll
                for (int bj = 0; bj < 2; ++bj) ra[ai][m][bj] = *(const u32x4*)(base + (size_t)(row0 + ai * HALF + m * 16) * 4096 + (g0 + 16 * bj) * 16);
        asm volatile("" ::: "memory");
#pragma unroll
        for (int ai = 0; ai < 2; ++ai)
#pragma unroll
            for (int m = 0; m < 4; ++m) { const int r = row0 + ai * HALF + m * 16; float q = 0.f;
#pragma unroll
                for (int bj = 0; bj < 2; ++bj) { const u32x4 a = ra[ai][m][bj]; float h[8];
                    h[0] = __uint_as_float(a.x << 16) + sc * acc[ai][bj][m][0][0]; h[1] = __uint_as_float(a.x & 0xffff0000u) + sc * acc[ai][bj][m][0][1]; h[2] = __uint_as_float(a.y << 16) + sc * acc[ai][bj][m][0][2]; h[3] = __uint_as_float(a.y & 0xffff0000u) + sc * acc[ai][bj][m][0][3];
                    h[4] = __uint_as_float(a.z << 16) + sc * acc[ai][bj][m][1][0]; h[5] = __uint_as_float(a.z & 0xffff0000u) + sc * acc[ai][bj][m][1][1]; h[6] = __uint_as_float(a.w << 16) + sc * acc[ai][bj][m][1][2]; h[7] = __uint_as_float(a.w & 0xffff0000u) + sc * acc[ai][bj][m][1][3];
                    u32x4 o; o.x = cvt_pk_bf16(h[0], h[1]); o.y = cvt_pk_bf16(h[2], h[3]); o.z = cvt_pk_bf16(h[4], h[5]); o.w = cvt_pk_bf16(h[6], h[7]);
                    if (xq) { typedef unsigned u32x2_ __attribute__((ext_vector_type(2))); u32x2_ w8; w8.x = pk_fp8x4(h[0], h[1], h[2], h[3]); w8.y = pk_fp8x4(h[4], h[5], h[6], h[7]); *(u32x2_*)(xq + (size_t)r * 1024 + (g0 + 16 * bj) * 8) = w8; }
                    const float s0 = __uint_as_float(o.x << 16), s1 = __uint_as_float(o.x & 0xffff0000u), s2 = __uint_as_float(o.y << 16), s3 = __uint_as_float(o.y & 0xffff0000u), s4 = __uint_as_float(o.z << 16), s5 = __uint_as_float(o.z & 0xffff0000u), s6 = __uint_as_float(o.w << 16), s7 = __uint_as_float(o.w & 0xffff0000u);
                    q += ((s0 * s0 + s1 * s1) + (s2 * s2 + s3 * s3)) + ((s4 * s4 + s5 * s5) + (s6 * s6 + s7 * s7));
                    *(u32x4*)(out + (size_t)r * 4096 + (g0 + 16 * bj) * 16) = o; }
                q = sum_x32(sum_x16(q));
                if (fq == 0) ssn[(size_t)r * 16 + u.pn * 4 + wc] = q; }
    }
};
template <bool RS_DIRECT> struct EpiSwiglu {
    static constexpr int PID = 3;
    static constexpr bool PERM = true, AFTER_DRAIN = false;
    bf16_t* O; int ldc; const float* ss;
    __device__ __forceinline__ void operator()(const f32x4 (&acc)[2][2][4][2], const Unit& u, int wr, int wc, int fr, int fq) const {
        const int row0 = u.pm * BM + wr * 64 + fr, col0 = u.pn * HALF + wc * 32 + 8 * fq;
        float rs[2][4];
        if (RS_DIRECT) {
#pragma unroll
            for (int ai = 0; ai < 2; ++ai)
#pragma unroll
                for (int m = 0; m < 4; ++m) rs[ai][m] = ss[row0 + ai * HALF + m * 16];
        } else row_rstd8(ss, row0, fq, rs);
#pragma unroll
        for (int ai = 0; ai < 2; ++ai)
#pragma unroll
            for (int m = 0; m < 4; ++m) { const int r = row0 + ai * HALF + m * 16; const float s = rs[ai][m];
                float a[8];
#pragma unroll
                for (int n = 0; n < 2; ++n)
#pragma unroll
                    for (int j2 = 0; j2 < 2; ++j2) { typedef float f2 __attribute__((ext_vector_type(2)));
                        const f2 g = (f2){acc[ai][0][m][n][2 * j2], acc[ai][0][m][n][2 * j2 + 1]} * s, up = (f2){acc[ai][1][m][n][2 * j2], acc[ai][1][m][n][2 * j2 + 1]} * s;
                        const f2 t = g * (-1.4426950408889634f); f2 e; e.x = __builtin_amdgcn_exp2f(t.x); e.y = __builtin_amdgcn_exp2f(t.y);
                        const f2 d = e + 1.0f; f2 rc; rc.x = __builtin_amdgcn_rcpf(d.x); rc.y = __builtin_amdgcn_rcpf(d.y);
                        const f2 o = (g * up) * rc; a[n * 4 + 2 * j2] = o.x; a[n * 4 + 2 * j2 + 1] = o.y; }
                u32x4 w; w.x = cvt_pk_bf16(a[0], a[1]); w.y = cvt_pk_bf16(a[2], a[3]); w.z = cvt_pk_bf16(a[4], a[5]); w.w = cvt_pk_bf16(a[6], a[7]);
                *(u32x4*)(O + (size_t)r * ldc + col0) = w; }
    }
};
template <bool ROWRS, bool W8 = true> struct EpiSwiglu8 {
    static constexpr int PID = 3;
    static constexpr bool PERM = true, AFTER_DRAIN = false;
    unsigned char* O; int ldc; const float* ss;
    __device__ __forceinline__ void operator()(const f32x4 (&acc)[2][2][4][2], const Unit& u, int wr, int wc, int fr, int fq) const {
        const int row0 = u.pm * BM + wr * 64 + fr, col0 = u.pn * HALF + wc * 32 + 8 * fq;
        float rs[2][4];
        if constexpr (ROWRS) row_rstd8(ss, row0, fq, rs);
#pragma unroll
        for (int ai = 0; ai < 2; ++ai)
#pragma unroll
            for (int m = 0; m < 4; ++m) { const int r = row0 + ai * HALF + m * 16;
                const float wsc = W8 ? 1.0f / F8_WGU : 1.0f, sg = ROWRS ? rs[ai][m] * wsc : wsc, su = sg * F8_ACT;
                float a[8];
#pragma unroll
                for (int n = 0; n < 2; ++n)
#pragma unroll
                    for (int j2 = 0; j2 < 2; ++j2) { typedef float f2 __attribute__((ext_vector_type(2)));
                        const f2 g = (f2){acc[ai][0][m][n][2 * j2], acc[ai][0][m][n][2 * j2 + 1]} * sg, up = (f2){acc[ai][1][m][n][2 * j2], acc[ai][1][m][n][2 * j2 + 1]} * su;
                        const f2 t = g * (-1.4426950408889634f); f2 e; e.x = __builtin_amdgcn_exp2f(t.x); e.y = __builtin_amdgcn_exp2f(t.y);
                        const f2 d = e + 1.0f; f2 rc; rc.x = __builtin_amdgcn_rcpf(d.x); rc.y = __builtin_amdgcn_rcpf(d.y);
                        const f2 o = (g * up) * rc; a[n * 4 + 2 * j2] = o.x; a[n * 4 + 2 * j2 + 1] = o.y; }
                typedef unsigned u32x2_ __attribute__((ext_vector_type(2)));
                u32x2_ w; w.x = pk_fp8x4(a[0], a[1], a[2], a[3]); w.y = pk_fp8x4(a[4], a[5], a[6], a[7]);
                *(u32x2_*)(O + (size_t)r * ldc + col0) = w; }
    }
};
struct EpiMoeDown0 {
    static constexpr int PID = 4;
    static constexpr bool PERM = true, AFTER_DRAIN = false;
    bf16_t* y0; const float* row_gate;
    __device__ __forceinline__ void operator()(const f32x4 (&acc)[2][2][4][2], const Unit& u, int wr, int wc, int fr, int fq) const {
        const int row0 = u.pm * BM + wr * 64 + fr, col0 = u.pn * BM + wc * 32 + 8 * fq;
        float gt[2][4];
#pragma unroll
        for (int ai = 0; ai < 2; ++ai)
#pragma unroll
            for (int m = 0; m < 4; ++m) gt[ai][m] = row_gate[row0 + ai * HALF + m * 16] * (1.0f / (F8_WD * F8_ACT));
#pragma unroll
        for (int ai = 0; ai < 2; ++ai)
#pragma unroll
            for (int m = 0; m < 4; ++m) { bf16_t* rowp = y0 + (size_t)(row0 + ai * HALF + m * 16) * 1024 + col0; const float s = gt[ai][m];
#pragma unroll
                for (int bj = 0; bj < 2; ++bj) { const f32x4 v0 = acc[ai][bj][m][0] * s, v1 = acc[ai][bj][m][1] * s;
                    u32x4 w; w.x = cvt_pk_bf16(v0[0], v0[1]); w.y = cvt_pk_bf16(v0[2], v0[3]); w.z = cvt_pk_bf16(v1[0], v1[1]); w.w = cvt_pk_bf16(v1[2], v1[3]);
                    *(u32x4*)(rowp + bj * HALF) = w; } }
    }
};
struct EpiMoeDown1 {
    static constexpr int PID = 4;
    static constexpr bool PERM = true, AFTER_DRAIN = false;
    unsigned char* h; float* ssn; const int* row_tok; const float* row_gate; const bf16_t* y0; const int* tok_row0;
    __device__ __forceinline__ void operator()(const f32x4 (&acc)[2][2][4][2], const Unit& u, int wr, int wc, int fr, int fq) const {
        const int row0 = u.pm * BM + wr * 64 + fr, g0 = u.pn * 32 + wc * 4 + fq;
#pragma unroll
        for (int ai = 0; ai < 2; ++ai) {
            u32x4 ra[4][2], ry[4][2]; int tk[4]; float gt[4];
#pragma unroll
            for (int m = 0; m < 4; ++m) { const int r = row0 + ai * HALF + m * 16; tk[m] = row_tok[r]; gt[m] = row_gate[r] * (1.0f / (F8_WD * F8_ACT)); }
#pragma unroll
            for (int m = 0; m < 4; ++m) { const int tc = tk[m] < 0 ? 0 : tk[m]; const int r0 = tok_row0[tc];
#pragma unroll
                for (int bj = 0; bj < 2; ++bj) { ra[m][bj] = *(const u32x4*)(h + (size_t)tc * 4096 + (g0 + 16 * bj) * 16); ry[m][bj] = *(const u32x4*)(y0 + (size_t)r0 * 1024 + (g0 + 16 * bj) * 8); } }
            asm volatile("" ::: "memory");
#pragma unroll
            for (int m = 0; m < 4; ++m) { const int tok = tk[m]; const float g = gt[m]; float q = 0.f;
                if (tok >= 0) {
#pragma unroll
                    for (int bj = 0; bj < 2; ++bj) { const u32x4 a = ra[m][bj], y = ry[m][bj]; float v[8];
                        v[0] = __uint_as_float(a.x << 16) + (__uint_as_float(y.x << 16) + g * acc[ai][bj][m][0][0]); v[1] = __uint_as_float(a.x & 0xffff0000u) + (__uint_as_float(y.x & 0xffff0000u) + g * acc[ai][bj][m][0][1]);
                        v[2] = __uint_as_float(a.y << 16) + (__uint_as_float(y.y << 16) + g * acc[ai][bj][m][0][2]); v[3] = __uint_as_float(a.y & 0xffff0000u) + (__uint_as_float(y.y & 0xffff0000u) + g * acc[ai][bj][m][0][3]);
                        v[4] = __uint_as_float(a.z << 16) + (__uint_as_float(y.z << 16) + g * acc[ai][bj][m][1][0]); v[5] = __uint_as_float(a.z & 0xffff0000u) + (__uint_as_float(y.z & 0xffff0000u) + g * acc[ai][bj][m][1][1]);
                        v[6] = __uint_as_float(a.w << 16) + (__uint_as_float(y.w << 16) + g * acc[ai][bj][m][1][2]); v[7] = __uint_as_float(a.w & 0xffff0000u) + (__uint_as_float(y.w & 0xffff0000u) + g * acc[ai][bj][m][1][3]);
                        u32x4 o; o.x = cvt_pk_bf16(v[0], v[1]); o.y = cvt_pk_bf16(v[2], v[3]); o.z = cvt_pk_bf16(v[4], v[5]); o.w = cvt_pk_bf16(v[6], v[7]);
                        const float s0 = __uint_as_float(o.x << 16), s1 = __uint_as_float(o.x & 0xffff0000u), s2 = __uint_as_float(o.y << 16), s3 = __uint_as_float(o.y & 0xffff0000u), s4 = __uint_as_float(o.z << 16), s5 = __uint_as_float(o.z & 0xffff0000u), s6 = __uint_as_float(o.w << 16), s7 = __uint_as_float(o.w & 0xffff0000u);
                        q += ((s0 * s0 + s1 * s1) + (s2 * s2 + s3 * s3)) + ((s4 * s4 + s5 * s5) + (s6 * s6 + s7 * s7));
                        *(u32x4*)(h + (size_t)tok * 4096 + (g0 + 16 * bj) * 16) = o; } }
                q = sum_x32(sum_x16(q)); if (fq == 0 && tok >= 0) ssn[(size_t)tok * 16 + u.pn * 4 + wc] = q; }
            asm volatile("" ::: "memory"); }
    }
};

typedef int i32x8 __attribute__((ext_vector_type(8)));
typedef short bf16x16 __attribute__((ext_vector_type(16)));
__device__ __forceinline__ f32x4 mfma_fp8_k128(bf16x8 b0, bf16x8 b1, bf16x8 a0, bf16x8 a1, f32x4 c) {
    const bf16x16 B = __builtin_shufflevector(b0, b1, 0, 1, 2, 3, 4, 5, 6, 7, 8, 9, 10, 11, 12, 13, 14, 15), A = __builtin_shufflevector(a0, a1, 0, 1, 2, 3, 4, 5, 6, 7, 8, 9, 10, 11, 12, 13, 14, 15);
    const i32x8 Bi = __builtin_bit_cast(i32x8, B), Ai = __builtin_bit_cast(i32x8, A);
    asm volatile("v_mfma_f32_16x16x128_f8f6f4 %0, %1, %2, %0" : "+v"(c) : "v"(Bi), "v"(Ai));
    return c;
}
template <class Epi, class Sched, bool ALIGN_EPI = false, bool SP2 = false>
__device__ __forceinline__ void gemm_phase(PG8_LAS unsigned char* lds, const int K, const Sched& S, const Epi& E, const int tid_in
#if defined(PROBE_SEC)
    , unsigned long long& pt_acc
#endif
    ) {
    int tid_o = tid_in; asm volatile("" : "+v"(tid_o));
    const int tid = tid_o, wid = __builtin_amdgcn_readfirstlane(tid >> 6), lane = tid & 63, wr = wid >> 2, wc = wid & 3, fr = lane & 15, fq = lane >> 4;
    const int nt = K / BK;
    unsigned voffA[2], voffB[2];
#pragma unroll
    for (int i = 0; i < 2; ++i) { int R, C; stage_rc(tid * 16 + i * 8192, R, C); const int Rb = Epi::PERM ? ((R & ~31) + perm32(R & 31)) : R;
        voffA[i] = Sched::A_HL ? (unsigned)(R * 4096 + C * 2) : (unsigned)(R * K + C) * 2u; voffB[i] = (unsigned)(Rb * K + C) * 2u; }
    unsigned gcur[2][2] = {{0u, 0u}, {0u, 0u}}, gnxt[2][2] = {{0u, 0u}, {0u, 0u}};
#define PG8_GOFF(dst, u) do { if constexpr (Sched::GATHER) { _Pragma("unroll") for (int _h = 0; _h < 2; ++_h) _Pragma("unroll") for (int _i = 0; _i < 2; ++_i) { int R_, C_; stage_rc(tid * 16 + _i * 8192, R_, C_); \
        dst[_h][_i] = Sched::A_HL ? (unsigned)S.a_row(u, _h * HALF + R_) * 4096u + (unsigned)(C_ * 2) : (unsigned)S.a_row(u, _h * HALF + R_) * (unsigned)(K * 2) + (unsigned)(C_ * 2); } } } while (0)
    const size_t kstepA = (size_t)(BK * 2), hstepA = Sched::A_HL ? (size_t)HALF * 4096 : (size_t)HALF * K * 2;
    const size_t kstep = (size_t)(BK * 2);
    const size_t hstep = (size_t)HALF * K * 2;
    const size_t tstep = 2 * hstep;
    const unsigned ldsw = (unsigned)wid * 1024u;
    const int aoff = lds_byte(wr * 64 + fr, fq * 8), boff = lds_byte(wc * 32 + fr, fq * 8);
#define PG8_SA(b, h) (((b) * 2 + (h)) * HTB)
#define PG8_SB(b, h) ((4 + (b) * 2 + (h)) * HTB)
#define PG8_STAGE(bufoff, gbase, voff) do { _Pragma("unroll") for (int _i = 0; _i < 2; ++_i) \
        __builtin_amdgcn_global_load_lds((const unsigned*)((const char*)(gbase) + (voff)[_i]), (PG8_LAS unsigned*)(lds + (bufoff) + ldsw + _i * 8192), 16, 0, 0); } while (0)
#define PG8_STAGE_A(bufoff, aptr, H, GO) do { _Pragma("unroll") for (int _i = 0; _i < 2; ++_i) \
        __builtin_amdgcn_global_load_lds((const unsigned*)((const char*)(aptr) + (Sched::GATHER ? GO[H][_i] : voffA[_i] + (unsigned)((H) * hstepA))), (PG8_LAS unsigned*)(lds + (bufoff) + ldsw + _i * 8192), 16, 0, 0); } while (0)
#define PG8_LDA(dst, b, h) do { _Pragma("unroll") for (int m = 0; m < 4; ++m) _Pragma("unroll") for (int k = 0; k < 2; ++k) dst[m][k] = *(const PG8_LAS bf16x8*)(lds + PG8_SA(b, h) + aoff + m * 2048 + k * 1024); } while (0)
#define PG8_LDB(dst, b, h) do { _Pragma("unroll") for (int n = 0; n < 2; ++n) _Pragma("unroll") for (int k = 0; k < 2; ++k) dst[n][k] = *(const PG8_LAS bf16x8*)(lds + PG8_SB(b, h) + boff + n * 2048 + k * 1024); } while (0)
#define PG8_MMA(ai, bj, At, Bt) do { __builtin_amdgcn_s_setprio(1); _Pragma("unroll") for (int m = 0; m < 4; ++m) _Pragma("unroll") for (int n = 0; n < 2; ++n) { \
        if constexpr (Sched::FP8) acc[ai][bj][m][n] = mfma_fp8_k128(Bt[n][0], Bt[n][1], At[m][0], At[m][1], acc[ai][bj][m][n]); \
        else { _Pragma("unroll") for (int k = 0; k < 2; ++k) acc[ai][bj][m][n] = __builtin_amdgcn_mfma_f32_16x16x32_bf16(Bt[n][k], At[m][k], acc[ai][bj][m][n], 0, 0, 0); } } __builtin_amdgcn_s_setprio(0); } while (0)
#define PG8_WAIT_V(n) asm volatile("s_waitcnt vmcnt(" #n ")" ::: "memory")
#define PG8_WAIT_L(n) asm volatile("s_waitcnt lgkmcnt(" #n ")" ::: "memory")
#define PG8_BAR __builtin_amdgcn_s_barrier()
#define PG8_SCHED __builtin_amdgcn_sched_barrier(0)
    Unit cur, nxt; int ui = 0;
    if (!S.next(0, cur)) return;
    f32x4 acc[2][2][4][2];
#pragma unroll
    for (int a = 0; a < 2; ++a)
#pragma unroll
        for (int b = 0; b < 2; ++b)
#pragma unroll
            for (int m = 0; m < 4; ++m)
#pragma unroll
                for (int n = 0; n < 2; ++n) { acc[a][b][m][n] = (f32x4){0.f, 0.f, 0.f, 0.f}; if constexpr (Sched::FP8) asm volatile("" : "+v"(acc[a][b][m][n])); }
    bf16x8 At[4][2], B0[2][2], B1[2][2];
    const char* cA = S.a_ptr(cur); const char* cB = S.b_ptr(cur);
    PG8_GOFF(gcur, cur);
    S.a_ready(cur);
    if constexpr (SP2) {
        PG8_STAGE(PG8_SB(0, 0), cB, voffB); PG8_STAGE(PG8_SB(0, 1), cB + hstep, voffB); PG8_STAGE_A(PG8_SA(0, 0), cA, 0, gcur); PG8_STAGE_A(PG8_SA(0, 1), cA, 1, gcur);
        if (wr == 1) PG8_BAR;
        PG8_WAIT_V(2); PG8_BAR;
        PG8_STAGE(PG8_SB(1, 0), cB + kstep, voffB); PG8_STAGE_A(PG8_SA(1, 0), cA + kstepA, 0, gcur); PG8_STAGE(PG8_SB(1, 1), cB + hstep + kstep, voffB);
        PG8_WAIT_V(6); PG8_BAR;
    } else {
        PG8_STAGE(PG8_SB(0, 0), cB, voffB); PG8_STAGE_A(PG8_SA(0, 0), cA, 0, gcur); PG8_STAGE(PG8_SB(0, 1), cB + hstep, voffB); PG8_STAGE_A(PG8_SA(0, 1), cA, 1, gcur);
        if (wr == 1) PG8_BAR;
        PG8_WAIT_V(4); PG8_BAR;
        PG8_STAGE(PG8_SB(1, 0), cB + kstep, voffB); PG8_STAGE_A(PG8_SA(1, 0), cA + kstepA, 0, gcur); PG8_STAGE(PG8_SB(1, 1), cB + hstep + kstep, voffB);
        PG8_WAIT_V(6); PG8_BAR;
    }
    for (;;) {
        const bool has_next = S.next(ui + 1, nxt);
        const char* nA = has_next ? S.a_ptr(nxt) : cA; const char* nB = has_next ? S.b_ptr(nxt) : cB;
        if (has_next) { PG8_GOFF(gnxt, nxt); } else { _Pragma("unroll") for (int _h = 0; _h < 2; ++_h) _Pragma("unroll") for (int _i = 0; _i < 2; ++_i) gnxt[_h][_i] = gcur[_h][_i]; }
        for (int t = 0; t < nt; t += 2) {
            const bool last = (t == nt - 2);
            const char* a1 = cA + (size_t)(t + 1) * kstepA;
            const char* a2 = last ? nA : cA + (size_t)(t + 2) * kstepA; const char* b2 = last ? nB : cB + (size_t)(t + 2) * kstep;
            const char* a3 = a2 + kstepA; const char* b3 = b2 + kstep;
            unsigned gsel[2][2]; _Pragma("unroll") for (int _h = 0; _h < 2; ++_h) _Pragma("unroll") for (int _i = 0; _i < 2; ++_i) gsel[_h][_i] = last ? gnxt[_h][_i] : gcur[_h][_i];
            if (last && has_next) S.a_ready(nxt);
            if constexpr (SP2) {
            PG8_LDB(B0, 0, 0); PG8_LDB(B1, 0, 1); PG8_SCHED; PG8_LDA(At, 0, 0); PG8_STAGE_A(PG8_SA(1, 1), a1, 1, gcur);
            PG8_WAIT_V(8); PG8_WAIT_L(0); PG8_BAR; PG8_MMA(0, 0, At, B0); PG8_MMA(0, 1, At, B1); PG8_BAR; PG8_SCHED;
            PG8_LDA(At, 0, 1); PG8_STAGE(PG8_SB(0, 0), b2, voffB); PG8_STAGE(PG8_SB(0, 1), b2 + hstep, voffB); PG8_STAGE_A(PG8_SA(0, 0), a2, 0, gsel);
            PG8_WAIT_V(8); PG8_WAIT_L(0); PG8_BAR; PG8_MMA(1, 0, At, B0); PG8_MMA(1, 1, At, B1); PG8_BAR; PG8_SCHED;
            PG8_LDB(B0, 1, 0); PG8_LDB(B1, 1, 1); PG8_SCHED; PG8_LDA(At, 1, 0); PG8_STAGE_A(PG8_SA(0, 1), a2, 1, gsel);
            PG8_WAIT_V(8); PG8_WAIT_L(0); PG8_BAR; PG8_MMA(0, 0, At, B0); PG8_MMA(0, 1, At, B1); PG8_BAR; PG8_SCHED;
            PG8_LDA(At, 1, 1); PG8_STAGE(PG8_SB(1, 0), b3, voffB); PG8_STAGE(PG8_SB(1, 1), b3 + hstep, voffB); PG8_STAGE_A(PG8_SA(1, 0), a3, 0, gsel);
            PG8_WAIT_V(8); PG8_WAIT_L(0); PG8_BAR; PG8_MMA(1, 0, At, B0); PG8_MMA(1, 1, At, B1); PG8_BAR; PG8_SCHED;
            } else {
            PG8_LDB(B0, 0, 0); PG8_SCHED; PG8_LDA(At, 0, 0); PG8_STAGE_A(PG8_SA(1, 1), a1, 1, gcur);
            PG8_WAIT_L(8); PG8_BAR; PG8_WAIT_L(0); PG8_MMA(0, 0, At, B0); PG8_BAR; PG8_SCHED;
            PG8_LDB(B1, 0, 1); PG8_STAGE(PG8_SB(0, 0), b2, voffB);
            PG8_BAR; PG8_WAIT_L(0); PG8_MMA(0, 1, At, B1); PG8_BAR;
            PG8_LDA(At, 0, 1); PG8_STAGE_A(PG8_SA(0, 0), a2, 0, gsel);
            PG8_BAR; PG8_WAIT_L(0); PG8_MMA(1, 0, At, B0); PG8_BAR; PG8_SCHED;
            PG8_STAGE(PG8_SB(0, 1), b2 + hstep, voffB);
            PG8_WAIT_V(6); PG8_BAR; PG8_MMA(1, 1, At, B1); PG8_BAR;
            PG8_LDB(B0, 1, 0); PG8_SCHED; PG8_LDA(At, 1, 0); PG8_STAGE_A(PG8_SA(0, 1), a2, 1, gsel);
            PG8_WAIT_L(8); PG8_BAR; PG8_WAIT_L(0); PG8_MMA(0, 0, At, B0); PG8_BAR; PG8_SCHED;
            PG8_LDB(B1, 1, 1); PG8_STAGE(PG8_SB(1, 0), b3, voffB);
            PG8_BAR; PG8_WAIT_L(0); PG8_MMA(0, 1, At, B1); PG8_BAR;
            PG8_LDA(At, 1, 1); PG8_STAGE_A(PG8_SA(1, 0), a3, 0, gsel);
            PG8_BAR; PG8_WAIT_L(0); PG8_MMA(1, 0, At, B0); PG8_BAR; PG8_SCHED;
            PG8_STAGE(PG8_SB(1, 1), b3 + hstep, voffB);
            PG8_WAIT_V(6); PG8_BAR; PG8_MMA(1, 1, At, B1); PG8_BAR;
            }
        }
        if constexpr (Sched::FP8) asm volatile("s_nop 15\n\ts_nop 15" ::: "memory");
        if constexpr (ALIGN_EPI) { if (wr == 0) PG8_BAR; }
#if defined(PROBE_SEC)
        unsigned long long pt_e0 = 0ull; if (Epi::PID + 10 == PROBE_SEC) pt_e0 = __builtin_amdgcn_s_memrealtime();
#endif
        if constexpr (!Epi::AFTER_DRAIN) { E(acc, cur, wr, wc, fr, fq); S.done(cur); }
#if defined(PROBE_SEC)
        if (Epi::PID + 10 == PROBE_SEC) { asm volatile("s_waitcnt vmcnt(0)" ::: "memory"); pt_acc += __builtin_amdgcn_s_memrealtime() - pt_e0; }
#endif
        if (!has_next) break;
#pragma unroll
        for (int a = 0; a < 2; ++a)
#pragma unroll
            for (int b = 0; b < 2; ++b)
#pragma unroll
                for (int m = 0; m < 4; ++m)
#pragma unroll
                    for (int n = 0; n < 2; ++n) { acc[a][b][m][n] = (f32x4){0.f, 0.f, 0.f, 0.f}; if constexpr (Sched::FP8) asm volatile("" : "+v"(acc[a][b][m][n])); }
        cur = nxt; cA = nA; cB = nB; ++ui; _Pragma("unroll") for (int _h = 0; _h < 2; ++_h) _Pragma("unroll") for (int _i = 0; _i < 2; ++_i) gcur[_h][_i] = gnxt[_h][_i];
        if constexpr (ALIGN_EPI) { if (wr == 1) PG8_BAR; }
    }
    PG8_WAIT_V(0);
    if constexpr (!ALIGN_EPI) { if (wr == 0) PG8_BAR; }
    PG8_BAR;
    if constexpr (Epi::AFTER_DRAIN) { E.fused(acc, cur, wr, wc, fr, fq, lds, wid, lane); S.done(cur); }
#undef PG8_SA
#undef PG8_SB
#undef PG8_STAGE
#undef PG8_STAGE_A
#undef PG8_GOFF
#undef PG8_LDA
#undef PG8_LDB
#undef PG8_MMA
#undef PG8_WAIT_V
#undef PG8_WAIT_L
#undef PG8_BAR
#undef PG8_SCHED
}
}

#define GAS __attribute__((address_space(1)))
#define LAS __attribute__((address_space(3)))
typedef unsigned short bf16;
typedef unsigned v4u __attribute__((ext_vector_type(4)));
typedef float f32x4 __attribute__((ext_vector_type(4)));
typedef short bf16x8 __attribute__((ext_vector_type(8)));
typedef GAS unsigned gu32;
typedef GAS unsigned long long gu64;
#define RLX_AGENT __ATOMIC_RELAXED, __HIP_MEMORY_SCOPE_AGENT
#define LDS_WAIT() asm volatile("s_waitcnt lgkmcnt(0)" ::: "memory")
#define VM_WAIT() asm volatile("s_waitcnt vmcnt(0)" ::: "memory")
__device__ __forceinline__ unsigned long long rt() { return __builtin_amdgcn_s_memrealtime(); }
__device__ __forceinline__ unsigned f2bf(float f) { unsigned u = __builtin_bit_cast(unsigned, f); return (u + 0x7fffu + ((u >> 16) & 1u)) >> 16; }
__device__ __forceinline__ unsigned pk2(float lo, float hi) { return f2bf(lo) | (f2bf(hi) << 16); }

#define XB_TMO      128
#define XB_XCNT(j)  (256  + 64 * (j))
#define XB_XSUB(j)  (1280 + 64 * (j))
#define XB_XGEN(j)  (2304 + 64 * (j))
#define XB_TOP      3328
#define XB_TOPGEN   3392
#define XCD_BAR_WORDS 3456
#define XB_SPIN_CAP (1u << 18)

__device__ __forceinline__ unsigned xb_ld(unsigned* p)              { return __hip_atomic_load(p, __ATOMIC_RELAXED, __HIP_MEMORY_SCOPE_AGENT); }
__device__ __forceinline__ unsigned xb_add(unsigned* p, unsigned v) { return __hip_atomic_fetch_add(p, v, __ATOMIC_RELAXED, __HIP_MEMORY_SCOPE_AGENT); }
__device__ __forceinline__ unsigned xb_xcc_id() { return (unsigned)__builtin_amdgcn_s_getreg((3 << 11) | 20) & 0xFu; }
#define XB_SPIN(cond, bar) do { unsigned _sp = 0; while (cond) { __builtin_amdgcn_s_sleep(1); \
    if ((++_sp & 255u) == 0u) { if (xb_ld(&(bar)[XB_TMO])) break; if (_sp > XB_SPIN_CAP) { atomicAdd(&(bar)[XB_TMO], 1u); break; } } } } while (0)

struct XcdBarrier {
    unsigned* bar; unsigned x;
    volatile LAS unsigned* st;
};

__device__ __forceinline__ XcdBarrier xcd_barrier_post(unsigned* bar, volatile LAS unsigned* st) {
    XcdBarrier b; b.bar = bar; b.x = xb_xcc_id(); b.st = st;
    if (threadIdx.x == 0) (void)xb_add(&bar[XB_XCNT(b.x)], 1u);
    return b;
}
__device__ __forceinline__ void xcd_barrier_complete(unsigned* bar, unsigned x, unsigned& nloc, unsigned& nx) {
    const unsigned G = gridDim.x * gridDim.y * gridDim.z;
    unsigned sum, cnt, mine, sp = 0u;
    for (;;) {
        sum = 0u; cnt = 0u; mine = 0u;
#pragma unroll
        for (unsigned j = 0; j < 16; ++j) { const unsigned c = xb_ld(&bar[XB_XCNT(j)]); sum += c; cnt += (c > 0u) ? 1u : 0u; mine = (j == x) ? c : mine; }
        if (sum == G) break;
        __builtin_amdgcn_s_sleep(1);
        if ((++sp & 255u) == 0u) { if (xb_ld(&bar[XB_TMO])) break; if (sp > XB_SPIN_CAP) { atomicAdd(&bar[XB_TMO], 1u); break; } }
    }
    nloc = mine > 0u ? mine : 1u; nx = cnt > 0u ? cnt : 1u;
}

__device__ __forceinline__ void xcd_barrier(const XcdBarrier& b, const int xb_tid  ) {
    asm volatile("s_waitcnt vmcnt(0)" ::: "memory");
    __syncthreads();
    if (xb_tid == 0) {
        unsigned* bar = b.bar;
        __builtin_amdgcn_s_waitcnt(0);
        unsigned nloc = b.st[0], nx = b.st[1];
        if (nloc == 0u) { xcd_barrier_complete(bar, b.x, nloc, nx); b.st[0] = nloc; b.st[1] = nx; }
        const unsigned old = xb_add(&bar[XB_XSUB(b.x)], 1u);
        const unsigned gen = old / nloc;
        if (old + 1u == (gen + 1u) * nloc) {
            __builtin_amdgcn_fence(__ATOMIC_RELEASE, "agent");
            asm volatile("s_waitcnt vmcnt(0)" ::: "memory");
            const unsigned og = xb_add(&bar[XB_TOP], 1u);
            const unsigned tg = og / nx;
            if (og + 1u == (tg + 1u) * nx) xb_add(&bar[XB_TOPGEN], 1u);
            else XB_SPIN(xb_ld(&bar[XB_TOPGEN]) == tg, bar);
            __builtin_amdgcn_fence(__ATOMIC_ACQUIRE, "agent");
            xb_add(&bar[XB_XGEN(b.x)], 1u);
            asm volatile("s_waitcnt vmcnt(0)" ::: "memory");
        } else {
            XB_SPIN(xb_ld(&bar[XB_XGEN(b.x)]) == gen, bar);
            __builtin_amdgcn_fence(__ATOMIC_ACQUIRE, "agent");
            asm volatile("s_waitcnt vmcnt(0)" ::: "memory");
        }
    }
    __syncthreads();
}

constexpr int NWAVES = 8;
constexpr int D = 1024, BATCH = 16, SEQ = 4096, DEPTH = 4, M = BATCH * SEQ;
constexpr int CHUNK = 64, NCHUNK = SEQ / CHUNK, MEM_LEN = 256, MROWS = BATCH * MEM_LEN;
constexpr int HG_H = 4, HG_D = 128, HG_W = 512, AT_H = 8, AT_D = 64, AT_W = 512, LEFTC = 8, MAXREL = 128, NREL = 257;
constexpr int INW = 3584;
constexpr int C_HQ = 0, C_HF = 512, C_HI = 1024, C_HGT = 1536, C_AQ = 2048, C_AK = 2560, C_AV = 3072;
constexpr int MH = 4, MHD = 256, FF = 2816, NE = 8, FFE = 3584;
constexpr int ROWS_PAD = M + NE * 256;
constexpr int MAXPANEL = ROWS_PAD / 256;
constexpr float EPS = 1e-6f;
enum { I_X = 0, I_MEM, I_WIN, I_LB, I_HGAIN, I_RELB, I_AGAIN, I_WOUT, I_NMIX, I_NMQ, I_NMKV, I_WMQ, I_WMKV, I_WMO, I_NFFN, I_WG, I_WU, I_WD, I_WR, I_EG, I_EU, I_ED, I_NFIN, N_IN };

constexpr size_t MiB = 1u << 20;
constexpr size_t WS_CTL = 0, CTL_ZERO_BYTES = 1 * MiB;
constexpr size_t WS_SS = 1 * MiB;
constexpr size_t WS_SSM = 5 * MiB;
constexpr size_t WS_RT = 8 * MiB;
constexpr size_t RT_TOKE = 0, RT_TOKG = 256 * 1024, RT_TOKRS = 768 * 1024, RT_ROWTOK = 1 * MiB, RT_ROWGATE = 1 * MiB + 768 * 1024, RT_ROWRS = 2 * MiB + 512 * 1024, RT_LB = 3 * MiB + 256 * 1024, RT_TOKROW0 = 3 * MiB + 512 * 1024;
constexpr size_t WS_MB = 12 * MiB;
constexpr size_t WS_KV = 20 * MiB;
constexpr size_t WS_W = 84 * MiB;
constexpr size_t W_LAYER = 13 * MiB, W_IN = 0, W_OUT = 7 * MiB, W_MQ = 9 * MiB, W_MO = 11 * MiB;
constexpr size_t W_KV = 52 * MiB;
constexpr size_t W_FFN = 68 * MiB, W_FFN_STRIDE = 17 * MiB, W_FFN_GU = 0, W_FFN_D = 11 * MiB;
constexpr size_t WS_WM = 188 * MiB, WM_ESTRIDE = 21 * MiB, WM_GU = 0, WM_D = 14 * MiB;
constexpr size_t WS_HB = 356 * MiB;
constexpr size_t WS_MIX = 484 * MiB;
constexpr size_t WS_BIG = 616 * MiB;
constexpr size_t WS_GV = 1078 * MiB;
constexpr size_t WS_END = 1084 * MiB;
static_assert(WS_W + W_FFN + 2 * W_FFN_STRIDE <= WS_WM && WS_WM + 8 * WM_ESTRIDE <= WS_HB && WS_MIX + (size_t)ROWS_PAD * D * 2 <= WS_BIG && WS_BIG + (size_t)ROWS_PAD * FFE * 2 <= WS_GV && WS_GV + (size_t)(M / 64) * 1536 * 4 <= WS_END, "ws map");
static_assert((size_t)5632 * 1024 * 2 <= W_FFN_D && W_FFN_D + (size_t)1024 * 2816 * 2 <= W_FFN_STRIDE && (size_t)7168 * 1024 * 2 <= WM_D && WM_D + (size_t)1024 * 3584 * 2 <= WM_ESTRIDE, "weight map");
constexpr int CW_TMO = 0, CW_CODE = 1, CW_BAR = 4096, CW_MOE = 16384, CW_SUB = 20480;
constexpr int RING_BYTES = 131072, LDSCTL_OFF = 149504, MISC_OFF = LDSCTL_OFF + 320, PEXP_OFF = LDSCTL_OFF + 1024, LDS_BYTES = 153600;
static_assert(PEXP_OFF + MAXPANEL * 4 + 64 <= LDS_BYTES, "LDS map");

typedef unsigned u32x2 __attribute__((ext_vector_type(2)));
__device__ __forceinline__ float bf2f(unsigned short b) { return __uint_as_float(((unsigned)b) << 16); }
__device__ __forceinline__ float bflo(unsigned w) { return __uint_as_float(w << 16); }
__device__ __forceinline__ float bfhi(unsigned w) { return __uint_as_float(w & 0xffff0000u); }
__device__ __forceinline__ unsigned cvtpk(float lo, float hi) { return pg8::cvt_pk_bf16(lo, hi); }
__device__ __forceinline__ float wave_sum(float v) { return pg8::sum_x32(pg8::sum_x16(pg8::row_sum16(v))); }
__device__ __forceinline__ float wave_max(float v) { return pg8::max_x32(pg8::max_x16(pg8::row_max16(v))); }
struct Args { const float* in[N_IN]; float* out; unsigned char* ws; int ph_lo, ph_hi, flags, pad; };

__device__ __forceinline__ void cvt_item(const float* W, int ldw, int K, const float* gain, bf16* WTrow, int k0, int n0, LAS unsigned* scr, int lane) {
    const int nq = (lane & 15) * 4, kq = lane >> 4;
    f32x4 va[8], vb[8];
#pragma unroll
    for (int i = 0; i < 8; ++i) { const int k = k0 + 8 * i + 2 * kq; va[i] = *(const GAS f32x4*)(W + (size_t)k * ldw + n0 + nq); vb[i] = *(const GAS f32x4*)(W + (size_t)(k + 1) * ldw + n0 + nq); }
#pragma unroll
    for (int i = 0; i < 8; ++i) { const int kl = 8 * i + 2 * kq; float g0 = 1.0f, g1 = 1.0f; if (gain) { g0 = gain[k0 + kl]; g1 = gain[k0 + kl + 1]; }
#pragma unroll
        for (int j = 0; j < 4; ++j) scr[(nq + j) * 33 + (kl >> 1)] = cvtpk(va[i][j] * g0, vb[i][j] * g1); }
    LDS_WAIT(); asm volatile("" ::: "memory");
#pragma unroll
    for (int i = 0; i < 8; ++i) { const int n = 8 * i + (lane >> 3), c = lane & 7; const LAS unsigned* s = scr + n * 33 + 4 * c;
        v4u o; o.x = s[0]; o.y = s[1]; o.z = s[2]; o.w = s[3];
        *(GAS v4u*)(WTrow + (size_t)n * K + k0 + 8 * c) = o; }
    LDS_WAIT(); asm volatile("" ::: "memory");
}
__device__ __forceinline__ void cvt_matrix(const float* W0, const float* W1, int K, int ldw, int NOUT, bf16* WT, const float* gain, LAS unsigned* scr, int lane, int& rot, int gw, int ngw) {
    const int nblk = NOUT / 64, items = (K / 64) * nblk;
    int w0 = gw - rot; if (w0 < 0) w0 += ngw;
    for (int it = w0; it < items; it += ngw) {
        const int kb = it / nblk, nb = it - kb * nblk, R0 = nb * 64; const float* W = W0; int n0 = R0;
        if (W1) { const int tile = R0 >> 8, rr = R0 & 255; W = (rr < 128) ? W0 : W1; n0 = tile * 128 + (rr & 127); }
        cvt_item(W, ldw, K, gain, WT + (size_t)R0 * K, kb * 64, n0, scr, lane);
    }
    rot = (rot + items) % ngw;
}
__device__ __forceinline__ void cvt_item8(const float* W, int ldw, int K, const float* gain, float sc, unsigned char* WTrow, int k0, int n0, LAS unsigned* scr, int lane) {
    const int nq = (lane & 15) * 4, kq = lane >> 4;
    f32x4 v[4][4];
#pragma unroll
    for (int i = 0; i < 4; ++i)
#pragma unroll
        for (int r = 0; r < 4; ++r) v[i][r] = *(const GAS f32x4*)(W + (size_t)(k0 + 16 * i + 4 * kq + r) * ldw + n0 + nq);
#pragma unroll
    for (int i = 0; i < 4; ++i) { const int kl = 16 * i + 4 * kq; float g[4] = {sc, sc, sc, sc};
        if (gain) { const f32x4 gv = *(const f32x4*)(gain + k0 + kl); g[0] = gv.x * sc; g[1] = gv.y * sc; g[2] = gv.z * sc; g[3] = gv.w * sc; }
#pragma unroll
        for (int j = 0; j < 4; ++j) scr[(nq + j) * 17 + (kl >> 2)] = pg8::pk_fp8x4(v[i][0][j] * g[0], v[i][1][j] * g[1], v[i][2][j] * g[2], v[i][3][j] * g[3]); }
    LDS_WAIT(); asm volatile("" ::: "memory");
#pragma unroll
    for (int i = 0; i < 4; ++i) { const int n = 16 * i + (lane >> 2), c = lane & 3; const LAS unsigned* s = scr + n * 17 + 4 * c;
        v4u o; o.x = s[0]; o.y = s[1]; o.z = s[2]; o.w = s[3];
        *(GAS v4u*)(WTrow + (size_t)n * K + k0 + 16 * c) = o; }
    LDS_WAIT(); asm volatile("" ::: "memory");
}
__device__ __forceinline__ void cvt_matrix8(const float* W0, const float* W1, int K, int ldw, int NOUT, unsigned char* WT, const float* gain, float sc, LAS unsigned* scr, int lane, int& rot, int gw, int ngw) {
    const int nblk = NOUT / 64, items = (K / 64) * nblk;
    int w0 = gw - rot; if (w0 < 0) w0 += ngw;
    for (int it = w0; it < items; it += ngw) {
        const int kb = it / nblk, nb = it - kb * nblk, R0 = nb * 64; const float* W = W0; int n0 = R0;
        if (W1) { const int tile = R0 >> 8, rr = R0 & 255; W = (rr < 128) ? W0 : W1; n0 = tile * 128 + (rr & 127); }
        cvt_item8(W, ldw, K, gain, sc, WT + (size_t)R0 * K, kb * 64, n0, scr, lane);
    }
    rot = (rot + items) % ngw;
}
__device__ __forceinline__ float row_to_bf16(const float* xrow, bf16* orow, int lane) {
    const GAS f32x4* xr = (const GAS f32x4*)xrow + lane; f32x4 v[4]; float s = 0.f;
#pragma unroll
    for (int j = 0; j < 4; ++j) { v[j] = xr[64 * j]; s += (v[j].x * v[j].x + v[j].y * v[j].y) + (v[j].z * v[j].z + v[j].w * v[j].w); }
    GAS u32x2* o8 = (GAS u32x2*)orow + lane;
#pragma unroll
    for (int j = 0; j < 4; ++j) { u32x2 w; w.x = cvtpk(v[j].x, v[j].y); w.y = cvtpk(v[j].z, v[j].w); o8[64 * j] = w; }
    return wave_sum(s);
}

__device__ __forceinline__ float row_to_stream(const float* xrow, unsigned char* srow, int lane) {
    float s = 0.f;
#pragma unroll
    for (int gq = 0; gq < 2; ++gq) { const int g = 64 * gq + lane; const f32x4 a = *(const GAS f32x4*)(xrow + 8 * g), c = *(const GAS f32x4*)(xrow + 8 * g + 4);
        const float h[8] = {a.x, a.y, a.z, a.w, c.x, c.y, c.z, c.w};
#pragma unroll
        for (int j = 0; j < 8; ++j) s += h[j] * h[j];
        pg8::hl_store8(srow + g * 16, h); }
    return wave_sum(s);
}
__device__ __forceinline__ void naive_chunk_attn(const bf16* PROJ, bf16* MIX, const float* relb  , int w0, int nw, int lane) {
    for (int u = w0; u < BATCH * NCHUNK * AT_H; u += nw) {
        const int h = u & 7, c = (u >> 3) & 63, b = u >> 9;
        const size_t rowq = (size_t)b * SEQ + c * CHUNK + lane;
        float q[64], o[64];
        { const v4u* qp = (const v4u*)(PROJ + rowq * INW + C_AQ + h * AT_D);
#pragma unroll
          for (int d8 = 0; d8 < 8; ++d8) { const v4u w = qp[d8]; q[d8 * 8 + 0] = bflo(w.x) * 0.125f; q[d8 * 8 + 1] = bfhi(w.x) * 0.125f; q[d8 * 8 + 2] = bflo(w.y) * 0.125f; q[d8 * 8 + 3] = bfhi(w.y) * 0.125f;
              q[d8 * 8 + 4] = bflo(w.z) * 0.125f; q[d8 * 8 + 5] = bfhi(w.z) * 0.125f; q[d8 * 8 + 6] = bflo(w.w) * 0.125f; q[d8 * 8 + 7] = bfhi(w.w) * 0.125f; } }
#pragma unroll
        for (int d = 0; d < 64; ++d) o[d] = 0.f;
        float mx = -1e30f, l = 0.f;
        const int klo = (c > LEFTC ? c - LEFTC : 0) * CHUNK, khi = c * CHUNK + CHUNK, qpos = c * CHUNK + lane;
        const float* bh = relb + h * NREL;
        for (int kp = klo; kp < khi; ++kp) {
            const bf16* kr = PROJ + ((size_t)b * SEQ + kp) * INW + C_AK + h * AT_D;
            float s = 0.f;
#pragma unroll
            for (int d8 = 0; d8 < 8; ++d8) { const v4u w = ((const v4u*)kr)[d8];
                s += q[d8 * 8 + 0] * bflo(w.x) + q[d8 * 8 + 1] * bfhi(w.x) + q[d8 * 8 + 2] * bflo(w.y) + q[d8 * 8 + 3] * bfhi(w.y) + q[d8 * 8 + 4] * bflo(w.z) + q[d8 * 8 + 5] * bfhi(w.z) + q[d8 * 8 + 6] * bflo(w.w) + q[d8 * 8 + 7] * bfhi(w.w); }
            int rel = qpos - kp; rel = rel < -MAXREL ? -MAXREL : (rel > MAXREL ? MAXREL : rel);
            s += bh[rel + MAXREL];
            const float mn = fmaxf(mx, s), al = __expf(mx - mn), p = __expf(s - mn);
            l = l * al + p; mx = mn;
            const bf16* vr = kr + (C_AV - C_AK);
#pragma unroll
            for (int d8 = 0; d8 < 8; ++d8) { const v4u w = ((const v4u*)vr)[d8];
                o[d8 * 8 + 0] = o[d8 * 8 + 0] * al + p * bflo(w.x); o[d8 * 8 + 1] = o[d8 * 8 + 1] * al + p * bfhi(w.x); o[d8 * 8 + 2] = o[d8 * 8 + 2] * al + p * bflo(w.y); o[d8 * 8 + 3] = o[d8 * 8 + 3] * al + p * bfhi(w.y);
                o[d8 * 8 + 4] = o[d8 * 8 + 4] * al + p * bflo(w.z); o[d8 * 8 + 5] = o[d8 * 8 + 5] * al + p * bfhi(w.z); o[d8 * 8 + 6] = o[d8 * 8 + 6] * al + p * bflo(w.w); o[d8 * 8 + 7] = o[d8 * 8 + 7] * al + p * bfhi(w.w); }
        }
        const float il = 1.0f / l;
        v4u* op = (v4u*)(MIX + rowq * D + HG_W + h * AT_D);
#pragma unroll
        for (int d8 = 0; d8 < 8; ++d8) { v4u w; w.x = cvtpk(o[d8 * 8 + 0] * il, o[d8 * 8 + 1] * il); w.y = cvtpk(o[d8 * 8 + 2] * il, o[d8 * 8 + 3] * il); w.z = cvtpk(o[d8 * 8 + 4] * il, o[d8 * 8 + 5] * il); w.w = cvtpk(o[d8 * 8 + 6] * il, o[d8 * 8 + 7] * il); op[d8] = w; }
    }
}
__device__ __forceinline__ void naive_hgrn(const bf16* PROJ, bf16* MIX, const float* lb  , int bh, LAS float* L, int tid) {
    const int b = bh >> 2, h = bh & 3;
    LAS float* Lf = L; LAS float* Lk = L + 8192; LAS float* Lq = L + 16384; LAS float* Lv = L + 24576;
    float S[128];
#pragma unroll
    for (int d = 0; d < 128; ++d) S[d] = 0.f;
    for (int c = 0; c < NCHUNK; ++c) {
        __syncthreads();
#pragma unroll 4
        for (int i = 0; i < 16; ++i) { const int idx = tid + 512 * i, t = idx >> 7, d = idx & 127;
            const bf16* pr = PROJ + ((size_t)b * SEQ + c * CHUNK + t) * INW + h * HG_D + d;
            const float qv = bf2f(pr[C_HQ]), fl = bf2f(pr[C_HF]), iv = bf2f(pr[C_HI]); const float lbv = lb[h * HG_D + d];
            const float f = lbv + (1.0f - lbv) / (1.0f + __expf(-fl));
            Lf[idx] = f; Lk[idx] = 1.0f - f; Lq[idx] = qv; Lv[idx] = iv; }
        __syncthreads();
        if (tid < 128) {
            for (int t = 0; t < CHUNK; ++t) {
                const float v = Lv[t * 128 + tid]; float o = 0.f;
#pragma unroll
                for (int d = 0; d < 128; d += 4) { const f32x4 f4 = *(const LAS f32x4*)(Lf + t * 128 + d), k4 = *(const LAS f32x4*)(Lk + t * 128 + d), q4 = *(const LAS f32x4*)(Lq + t * 128 + d);
                    S[d + 0] = S[d + 0] * f4.x + k4.x * v; o += q4.x * S[d + 0]; S[d + 1] = S[d + 1] * f4.y + k4.y * v; o += q4.y * S[d + 1];
                    S[d + 2] = S[d + 2] * f4.z + k4.z * v; o += q4.z * S[d + 2]; S[d + 3] = S[d + 3] * f4.w + k4.w * v; o += q4.w * S[d + 3]; }
                MIX[((size_t)b * SEQ + c * CHUNK + t) * D + h * HG_D + tid] = (bf16)f2bf(o);
            }
        }
    }
    __syncthreads();
}
__device__ __forceinline__ void post_rows(bf16* MIX, const float* again, int w0, int nw, int lane) {
    float ga[8];
#pragma unroll
    for (int j = 0; j < 8; ++j) ga[j] = again[lane * 8 + j];
    for (int r0 = w0; r0 < M; r0 += 4 * nw) {
        v4u w[4];
#pragma unroll
        for (int q = 0; q < 4; ++q) { const int r = r0 + q * nw; w[q] = (r < M) ? ((const v4u*)(MIX + (size_t)r * D))[64 + lane] : (v4u){0u, 0u, 0u, 0u}; }
#pragma unroll
        for (int q = 0; q < 4; ++q) { const int r = r0 + q * nw; if (r < M) {
            const float x[8] = {bflo(w[q].x), bfhi(w[q].x), bflo(w[q].y), bfhi(w[q].y), bflo(w[q].z), bfhi(w[q].z), bflo(w[q].w), bfhi(w[q].w)};
            float ss = 0.f;
#pragma unroll
            for (int j = 0; j < 8; ++j) ss += x[j] * x[j];
            ss = wave_sum(ss); const float rs = 1.0f / sqrtf(ss * (1.0f / 512.0f) + EPS);
            v4u o; o.x = cvtpk(x[0] * rs * ga[0], x[1] * rs * ga[1]); o.y = cvtpk(x[2] * rs * ga[2], x[3] * rs * ga[3]); o.z = cvtpk(x[4] * rs * ga[4], x[5] * rs * ga[5]); o.w = cvtpk(x[6] * rs * ga[6], x[7] * rs * ga[7]);
            ((v4u*)(MIX + (size_t)r * D))[64 + lane] = o; } }
    }
}
__device__ __forceinline__ void naive_mem_attn(const bf16* Q, const bf16* KV, bf16* O, int layer, int w0, int nw, int lane) {
    for (int u = w0; u < BATCH * MH * SEQ; u += nw) {
        const int qi = u & (SEQ - 1), h = (u >> 12) & 3, b = u >> 14;
        const size_t row = (size_t)b * SEQ + qi;
        const bf16* Qp = Q + row * D + h * MHD;
        const bf16* Kb = KV + (size_t)b * MEM_LEN * (DEPTH * 2048) + layer * 2048 + h * MHD; const bf16* Vb = Kb + 1024;
        float s[4] = {0.f, 0.f, 0.f, 0.f};
#pragma unroll 4
        for (int d8 = 0; d8 < 32; ++d8) { const v4u qw = ((const v4u*)Qp)[d8]; const float qf[8] = {bflo(qw.x), bfhi(qw.x), bflo(qw.y), bfhi(qw.y), bflo(qw.z), bfhi(qw.z), bflo(qw.w), bfhi(qw.w)};
#pragma unroll
            for (int i = 0; i < 4; ++i) { const v4u kw = *(const v4u*)(Kb + (size_t)(lane + 64 * i) * (DEPTH * 2048) + d8 * 8);
                s[i] += qf[0] * bflo(kw.x) + qf[1] * bfhi(kw.x) + qf[2] * bflo(kw.y) + qf[3] * bfhi(kw.y) + qf[4] * bflo(kw.z) + qf[5] * bfhi(kw.z) + qf[6] * bflo(kw.w) + qf[7] * bfhi(kw.w); } }
        float mx = -1e30f;
#pragma unroll
        for (int i = 0; i < 4; ++i) { s[i] *= 0.0625f; mx = fmaxf(mx, s[i]); }
        mx = wave_max(mx); float p[4], sum = 0.f;
#pragma unroll
        for (int i = 0; i < 4; ++i) { p[i] = __expf(s[i] - mx); sum += p[i]; }
        sum = wave_sum(sum);
        float o0 = 0.f, o1 = 0.f, o2 = 0.f, o3 = 0.f;
#pragma unroll
        for (int i = 0; i < 4; ++i) {
#pragma unroll 8
            for (int kk = 0; kk < 64; ++kk) { const float pk = __shfl(p[i], kk); const u32x2 vw = *(const u32x2*)(Vb + (size_t)(kk + 64 * i) * (DEPTH * 2048) + lane * 4);
                o0 += pk * bflo(vw.x); o1 += pk * bfhi(vw.x); o2 += pk * bflo(vw.y); o3 += pk * bfhi(vw.y); } }
        const float il = 1.0f / sum; u32x2 w; w.x = cvtpk(o0 * il, o1 * il); w.y = cvtpk(o2 * il, o3 * il);
        *(u32x2*)(O + row * D + h * MHD + lane * 4) = w;
    }
}

#if defined(PROBE_SEC)
#define PT_BEGIN(n) unsigned long long pt_t0_##n = 0ull; if ((n) == PROBE_SEC) pt_t0_##n = __builtin_amdgcn_s_memrealtime();
#define PT_END(n) if ((n) == PROBE_SEC) pt_acc += __builtin_amdgcn_s_memrealtime() - pt_t0_##n;
#define PT_PARAM , unsigned long long& pt_acc
#else
#define PT_BEGIN(n)
#define PT_END(n)
#define PT_PARAM
#endif

typedef float f32x16 __attribute__((ext_vector_type(16)));
typedef short s16x4 __attribute__((ext_vector_type(4)));
typedef short v4i16_t __attribute__((ext_vector_type(4)));
typedef float f32x2t __attribute__((ext_vector_type(2)));
typedef __bf16 bf16x2t __attribute__((ext_vector_type(2)));
__device__ __forceinline__ unsigned cvtpk_c(float lo, float hi) { f32x2t v = {lo, hi}; bf16x2t b = __builtin_convertvector(v, bf16x2t); return __builtin_bit_cast(unsigned, b); }
__device__ __forceinline__ s16x4 vtr(const LAS unsigned char* p) { return __builtin_bit_cast(s16x4, __builtin_amdgcn_ds_read_tr16_b64_v4i16((LAS v4i16_t*)p)); }
#define MFMA32(a, b, c) __builtin_amdgcn_mfma_f32_32x32x16_bf16((a), (b), (c), 0, 0, 0)
__device__ __forceinline__ int crow16(int i, int hh) { return (i & 3) + 8 * (i >> 2) + 4 * hh; }
__device__ __forceinline__ bf16x8 pack8(const f32x16& x, int s) {
    v4u w; w.x = cvtpk_c(x[8 * s + 0], x[8 * s + 1]); w.y = cvtpk_c(x[8 * s + 2], x[8 * s + 3]); w.z = cvtpk_c(x[8 * s + 4], x[8 * s + 5]); w.w = cvtpk_c(x[8 * s + 6], x[8 * s + 7]);
    return __builtin_bit_cast(bf16x8, w);
}

typedef int i32x8m __attribute__((ext_vector_type(8)));
typedef unsigned u32x8m __attribute__((ext_vector_type(8)));
__device__ __forceinline__ f32x16 mfma8_32x32x64(v4u a0, v4u a1, v4u b0, v4u b1, f32x16 c) {
    const u32x8m A = __builtin_shufflevector(a0, a1, 0, 1, 2, 3, 4, 5, 6, 7), B = __builtin_shufflevector(b0, b1, 0, 1, 2, 3, 4, 5, 6, 7);
    const i32x8m Ai = __builtin_bit_cast(i32x8m, A), Bi = __builtin_bit_cast(i32x8m, B);
    asm volatile("v_mfma_f32_32x32x64_f8f6f4 %0, %1, %2, %0" : "+v"(c) : "v"(Ai), "v"(Bi));
    return c;
}
__device__ __forceinline__ void mem_attn_phase(const unsigned char* Q8, const bf16* KVb, unsigned char* O8, int layer, LAS unsigned char* L, int tid, int bx, int G PT_PARAM) {
    const int lane = tid & 63, wid = __builtin_amdgcn_readfirstlane(tid >> 6), r = lane & 31, hh = lane >> 5;
    constexpr int KVLD = DEPTH * 2048;
    const int fx = ((r & 3) << 2) | ((r >> 2) & 3);
    const int tq = (lane & 15) >> 2, tp = lane & 3, tb = (lane >> 4) & 1;
    const float csc = 0.0625f * 1.4426950408889634f / (pg8::F8_Q * pg8::F8_K);
    for (int u = bx; u < BATCH * MH * 16; u += G) {
        const int qb = u & 15, h = (u >> 4) & 3, b = u >> 6;
        const bf16* Vb = KVb + (size_t)(b * MEM_LEN) * KVLD + layer * 2048 + 1024 + h * MHD;
        const unsigned char* K8b = (const unsigned char*)KVb + (size_t)(b * MEM_LEN) * (KVLD * 2) + layer * 4096 + h * MHD;
        const size_t rowq0 = (size_t)b * SEQ + qb * 256 + wid * 32;
        v4u qf[8];
        const unsigned char* qp = Q8 + (rowq0 + r) * D + h * MHD + hh * 16;
#pragma unroll
        for (int i = 0; i < 8; ++i) qf[i] = *(const v4u*)(qp + i * 32);
        f32x16 sacc[8];
#pragma unroll
        for (int i = 0; i < 8; ++i)
#pragma unroll
            for (int j = 0; j < 16; ++j) sacc[i][j] = 0.f;
        bf16x8 pf[8][2]; f32x16 oacc[8]; float inv = 0.f;
#define MA_DMA_K(s, bufo) do { const int kvh_ = (s); int ln_ = lane; asm volatile("" : "+v"(ln_));   \
        _Pragma("unroll") for (int i_ = 0; i_ < 4; ++i_) { const int row_ = 16 * wid + 4 * i_ + (ln_ >> 4); \
            const int ch_ = (ln_ & 15) ^ (((row_ & 3) << 2) | ((row_ >> 2) & 3)); \
            __builtin_amdgcn_global_load_lds((const unsigned*)(K8b + (size_t)(128 * kvh_ + row_) * (KVLD * 2) + ch_ * 16), (LAS unsigned*)(L + (bufo) + (16 * wid + 4 * i_) * 256), 16, 0, 0); } } while (0)
#define MA_DMA_V(j, bufo) do { int ln_ = lane; asm volatile("" : "+v"(ln_)); _Pragma("unroll") for (int i_ = 0; i_ < 4; ++i_) { const int pc_ = wid * 4 + i_, dblk_ = pc_ >> 2, rg_ = pc_ & 3, row_ = rg_ * 16 + (ln_ >> 2); \
            __builtin_amdgcn_global_load_lds((const unsigned*)(Vb + (size_t)(64 * (j) + row_) * KVLD + dblk_ * 32 + (ln_ & 3) * 8), (LAS unsigned*)(L + (bufo) + pc_ * 1024), 16, 0, 0); } } while (0)
        MA_DMA_K(0, 0); MA_DMA_K(1, 32768);
#pragma unroll
        for (int s = 0; s < 6; ++s) {
            const int bufo = (s % 3) * 32768, nbufo = ((s + 2) % 3) * 32768;
            PT_BEGIN(31)
            if (s < 5) asm volatile("s_waitcnt vmcnt(4)" ::: "memory"); else asm volatile("s_waitcnt vmcnt(0)" ::: "memory");
            __syncthreads();
            if (s + 2 < 6) MA_DMA_V(s, nbufo);
            PT_END(31)
            PT_BEGIN(32)
            if (s < 2) {
                const int kvh = s;
#pragma unroll
                for (int blk = 0; blk < 4; ++blk) { const LAS unsigned char* rp = L + bufo + (32 * blk + r) * 256; v4u kf[8];
#pragma unroll
                    for (int i = 0; i < 8; ++i) kf[i] = *(const LAS v4u*)(rp + (((2 * i + hh) ^ fx) << 4));
                    __builtin_amdgcn_sched_barrier(0);
#pragma unroll
                    for (int j = 0; j < 4; ++j) sacc[4 * kvh + blk] = mfma8_32x32x64(kf[2 * j], kf[2 * j + 1], qf[2 * j], qf[2 * j + 1], sacc[4 * kvh + blk]);
                    __builtin_amdgcn_sched_barrier(0); }
                if (s == 1) { asm volatile("s_nop 15\n\ts_nop 15\n\ts_nop 7" ::: "memory");
                    float sum = 0.f;
#pragma unroll
                    for (int i = 0; i < 8; ++i) {
#pragma unroll
                        for (int j = 0; j < 16; ++j) { const float p = __builtin_amdgcn_exp2f(sacc[i][j] * csc - 8.0f); sacc[i][j] = p; sum += p; }
                        pf[i][0] = pack8(sacc[i], 0); pf[i][1] = pack8(sacc[i], 1); }
                    sum = pg8::sum_x32(sum); inv = 1.0f / sum;
#pragma unroll
                    for (int i = 0; i < 8; ++i)
#pragma unroll
                        for (int j = 0; j < 16; ++j) oacc[i][j] = 0.f;
                }
            } else {
                const int j = s - 2;
                int lv_ = lane; asm volatile("" : "+v"(lv_));
                const LAS unsigned char* vbase = L + bufo + (4 * (lv_ >> 5) + ((lv_ & 15) >> 2)) * 64 + ((lv_ >> 4) & 1) * 32 + (lv_ & 3) * 8;
#pragma unroll
                for (int dblk = 0; dblk < 8; ++dblk) { s16x4 lo[4], hi[4];
#pragma unroll
                    for (int q4 = 0; q4 < 4; ++q4) { const LAS unsigned char* vp = vbase + dblk * 4096 + (32 * (q4 >> 1) + 16 * (q4 & 1)) * 64; lo[q4] = vtr(vp); hi[q4] = vtr(vp + 512); }
                    __builtin_amdgcn_sched_barrier(0);
#pragma unroll
                    for (int q4 = 0; q4 < 4; ++q4) { const bf16x8 a = {lo[q4][0], lo[q4][1], lo[q4][2], lo[q4][3], hi[q4][0], hi[q4][1], hi[q4][2], hi[q4][3]};
                        oacc[dblk] = MFMA32(a, pf[2 * j + (q4 >> 1)][q4 & 1], oacc[dblk]); }
                    __builtin_amdgcn_sched_barrier(0); }
            }
            PT_END(32)
        }
#undef MA_DMA_K
#undef MA_DMA_V
        PT_BEGIN(34)
        __syncthreads();
        LAS unsigned char* stg = L + wid * 4608;
        const float invs = inv * pg8::F8_O;
#pragma unroll
        for (int hf = 0; hf < 2; ++hf) {
#pragma unroll
            for (int db = 0; db < 4; ++db)
#pragma unroll
                for (int g = 0; g < 4; ++g) { const f32x16& o = oacc[4 * hf + db];
                    *(LAS unsigned*)(stg + r * 144 + (32 * db + 8 * g + 4 * hh)) = pg8::pk_fp8x4(o[4 * g] * invs, o[4 * g + 1] * invs, o[4 * g + 2] * invs, o[4 * g + 3] * invs); }
#pragma unroll
            for (int it = 0; it < 4; ++it) { const int id = it * 64 + lane, row = id >> 3, ch = id & 7; const v4u v = *(const LAS v4u*)(stg + row * 144 + ch * 16);
                *(v4u*)(O8 + (rowq0 + row) * D + h * MHD + hf * 128 + ch * 16) = v; }
        }
        __syncthreads();
        PT_END(34)
    }
}

__device__ __forceinline__ void chunk_attn_phase(const bf16* PROJ, bf16* MIX, const float* relb, LAS unsigned char* L, int tid, int u0, int ustride PT_PARAM) {
    const int lane = tid & 63, wid = __builtin_amdgcn_readfirstlane(tid >> 6), r = lane & 31, hh = lane >> 5;
    const int tq = (lane & 15) >> 2, tp = lane & 3, tb = (lane >> 4) & 1;
    LAS float* bt = (LAS float*)(L + 98304);
    const float LOG2E = 1.4426950408889634f;
    for (int u = u0; u < BATCH * AT_H * 16; u += ustride) {
        const int qblk = u & 15, h = (u >> 4) & 7, b = u >> 7;
        PT_BEGIN(23)
        for (int i = tid; i < NREL; i += NWAVES * 64) bt[i] = relb[h * NREL + i] * LOG2E - 8.0f;
        const int cq = 4 * qblk + (wid >> 1), qin = 32 * (wid & 1) + r;
        const size_t rowq0 = (size_t)b * SEQ + cq * CHUNK + 32 * (wid & 1);
        bf16x8 qf[4];
        { const bf16* qp = PROJ + (rowq0 + r) * INW + C_AQ + h * AT_D + hh * 8;
#pragma unroll
          for (int ks = 0; ks < 4; ++ks) qf[ks] = *(const bf16x8*)(qp + ks * 16); }
        const int c_lo = (4 * qblk > LEFTC) ? 4 * qblk - LEFTC : 0, nt = 4 * qblk + 4 - c_lo;
        float l = 0.f; f32x16 oacc[2];
#pragma unroll
        for (int j = 0; j < 16; ++j) { oacc[0][j] = 0.f; oacc[1][j] = 0.f; }
#define CA_DMA(ct, bufo) do { const size_t kv0_ = (size_t)b * SEQ + (size_t)(ct) * CHUNK; \
            { const int row_ = 8 * wid + (lane >> 3), ch_ = (lane & 7) ^ (row_ & 7); \
              __builtin_amdgcn_global_load_lds((const unsigned*)(PROJ + (kv0_ + row_) * INW + C_AK + h * AT_D + ch_ * 8), (LAS unsigned*)(L + (bufo) + wid * 1024), 16, 0, 0); } \
            { const int row_ = 16 * (wid & 3) + (lane >> 2); \
              __builtin_amdgcn_global_load_lds((const unsigned*)(PROJ + (kv0_ + row_) * INW + C_AV + h * AT_D + (wid >> 2) * 32 + (lane & 3) * 8), (LAS unsigned*)(L + (bufo) + 8192 + wid * 1024), 16, 0, 0); } } while (0)
        CA_DMA(c_lo, 0); if (nt > 1) CA_DMA(c_lo + 1, 16384);
        PT_END(23)
        int bufo = 0, nbufo = 32768;
        for (int it = 0; it < nt; ++it) {
            const int ct = c_lo + it;
            PT_BEGIN(21)
            if (it + 1 < nt) asm volatile("s_waitcnt vmcnt(2)" ::: "memory"); else asm volatile("s_waitcnt vmcnt(0)" ::: "memory");
            __syncthreads();
            if (it + 2 < nt) CA_DMA(ct + 2, nbufo);
            PT_END(21)
            PT_BEGIN(22)
            const int dist = cq - ct;
            if (dist >= 0 && dist <= LEFTC) {
                f32x16 sb[2];
                { bf16x8 kf[2][4];
#pragma unroll
                  for (int blk = 0; blk < 2; ++blk) { const LAS unsigned char* rp = L + bufo + (32 * blk + r) * 128;
#pragma unroll
                      for (int ks = 0; ks < 4; ++ks) kf[blk][ks] = *(const LAS bf16x8*)(rp + (((2 * ks + hh) ^ (r & 7)) << 4)); }
                  __builtin_amdgcn_sched_barrier(0);
#pragma unroll
                  for (int blk = 0; blk < 2; ++blk) {
#pragma unroll
                      for (int j = 0; j < 16; ++j) sb[blk][j] = 0.f;
#pragma unroll
                      for (int ks = 0; ks < 4; ++ks) sb[blk] = MFMA32(kf[blk][ks], qf[ks], sb[blk]); }
                  __builtin_amdgcn_sched_barrier(0); }
                const float sc = 0.125f * LOG2E;
                if (dist >= 3) { const float bc = bt[2 * MAXREL];
#pragma unroll
                    for (int blk = 0; blk < 2; ++blk)
#pragma unroll
                        for (int j = 0; j < 16; ++j) sb[blk][j] = sb[blk][j] * sc + bc;
                } else { const int rel0 = CHUNK * dist + qin - 4 * hh + MAXREL;
#pragma unroll
                    for (int blk = 0; blk < 2; ++blk)
#pragma unroll
                        for (int j = 0; j < 16; ++j) { int ix = rel0 - 32 * blk - ((j & 3) + 8 * (j >> 2)); ix = ix < 0 ? 0 : (ix > 2 * MAXREL ? 2 * MAXREL : ix); sb[blk][j] = sb[blk][j] * sc + bt[ix]; } }
                float ls = 0.f;
#pragma unroll
                for (int blk = 0; blk < 2; ++blk)
#pragma unroll
                    for (int j = 0; j < 16; ++j) { const float p = __builtin_amdgcn_exp2f(sb[blk][j]); sb[blk][j] = p; ls += p; }
                l += ls;
                bf16x8 pf[2][2];
#pragma unroll
                for (int blk = 0; blk < 2; ++blk) { pf[blk][0] = pack8(sb[blk], 0); pf[blk][1] = pack8(sb[blk], 1); }
                { s16x4 lo[2][4], hi[2][4];
#pragma unroll
                  for (int dblk = 0; dblk < 2; ++dblk)
#pragma unroll
                      for (int q4 = 0; q4 < 4; ++q4) { const LAS unsigned char* vp = L + bufo + 8192 + dblk * 4096 + (32 * (q4 >> 1) + 16 * (q4 & 1) + 4 * hh + tq) * 64 + tb * 32 + tp * 8; lo[dblk][q4] = vtr(vp); hi[dblk][q4] = vtr(vp + 512); }
                  __builtin_amdgcn_sched_barrier(0);
#pragma unroll
                  for (int dblk = 0; dblk < 2; ++dblk)
#pragma unroll
                      for (int q4 = 0; q4 < 4; ++q4) { const bf16x8 a = {lo[dblk][q4][0], lo[dblk][q4][1], lo[dblk][q4][2], lo[dblk][q4][3], hi[dblk][q4][0], hi[dblk][q4][1], hi[dblk][q4][2], hi[dblk][q4][3]};
                          oacc[dblk] = MFMA32(a, pf[q4 >> 1][q4 & 1], oacc[dblk]); }
                  __builtin_amdgcn_sched_barrier(0); }
            }
            PT_END(22)
            bufo = (bufo == 32768) ? 0 : bufo + 16384; nbufo = (nbufo == 32768) ? 0 : nbufo + 16384;
        }
#undef CA_DMA
        PT_BEGIN(24)
        l = pg8::sum_x32(l); const float inv = 1.0f / l;
        LAS unsigned char* stg = L + 49152 + wid * 4608;
#pragma unroll
        for (int dblk = 0; dblk < 2; ++dblk)
#pragma unroll
            for (int g = 0; g < 4; ++g) { const f32x16& o = oacc[dblk]; u32x2 w; w.x = cvtpk_c(o[4 * g] * inv, o[4 * g + 1] * inv); w.y = cvtpk_c(o[4 * g + 2] * inv, o[4 * g + 3] * inv);
                *(LAS u32x2*)(stg + r * 144 + (32 * dblk + 8 * g + 4 * hh) * 2) = w; }
#pragma unroll
        for (int it = 0; it < 4; ++it) { const int id = it * 64 + lane, row = id >> 3, ch = id & 7; const v4u v = *(const LAS v4u*)(stg + row * 144 + ch * 16);
            *(v4u*)(MIX + (rowq0 + row) * D + HG_W + h * AT_D + ch * 8) = v; }
        __syncthreads();
        PT_END(24)
    }
}


constexpr int HL_QH = 0, HL_KH = 32768, HL_V0 = 65536, HL_SIMG = 98304, HL_RED = 131072, HL_GN = 132096, HL_END = 132608;
__device__ __forceinline__ int offb_key(int row) { return ((row & 3) << 2) | ((row >> 2) & 3); }
__device__ __forceinline__ void hgrn_phase(const bf16* PROJ, bf16* MIX, const float* gv, int bh, LAS unsigned char* L, int tid
#if defined(PROBE_SEC)
    , unsigned long long& pt_acc
#endif
    ) {
    const int lane0 = tid & 63, wid = __builtin_amdgcn_readfirstlane(tid >> 6);
    const int b = bh >> 2, h = bh & 3, eb = wid & 3, tb = wid >> 2;
#define HG_LANES() int lane = lane0; asm volatile("" : "+v"(lane)); const int r = lane & 31, hh = lane >> 5, tq = (lane & 15) >> 2, tp = lane & 3, tbit = (lane >> 4) & 1, fx = offb_key(r); \
    (void)r; (void)hh; (void)tq; (void)tp; (void)tbit; (void)fx;
    const float LOG2E = 1.4426950408889634f;
    const bf16* Pb = PROJ + (size_t)b * SEQ * INW;
    const float* gvb = gv + (size_t)(b * NCHUNK) * 1536 + h * HG_D;
    f32x16 st[2];
#pragma unroll
    for (int j = 0; j < 16; ++j) { st[0][j] = 0.f; st[1][j] = 0.f; }
#define HG_DMA(c, ib) do { const bf16* src_ = Pb + (size_t)((c) * CHUNK) * INW; _Pragma("unroll") for (int i_ = 0; i_ < 2; ++i_) { const int row_ = 8 * wid + 4 * i_ + (lane >> 4), cv_ = (lane & 15) ^ offb_key(row_); \
        __builtin_amdgcn_global_load_lds((const unsigned*)(src_ + (size_t)row_ * INW + 256 * h + cv_ * 8), (LAS unsigned*)(L + HL_QH + (ib) * 16384 + (8 * wid + 4 * i_) * 256), 16, 0, 0); \
        __builtin_amdgcn_global_load_lds((const unsigned*)(src_ + (size_t)row_ * INW + 256 * h + 128 + cv_ * 8), (LAS unsigned*)(L + HL_KH + (ib) * 16384 + (8 * wid + 4 * i_) * 256), 16, 0, 0); \
        __builtin_amdgcn_global_load_lds((const unsigned*)(src_ + (size_t)row_ * INW + C_HI + h * HG_D + cv_ * 8), (LAS unsigned*)(L + HL_V0 + (ib) * 16384 + (8 * wid + 4 * i_) * 256), 16, 0, 0); } } while (0)
    { HG_LANES();
      HG_DMA(0, 0);
      unsigned z_ = 0u; asm volatile("" : "+v"(z_));
      for (int i = tid; i < 32768 / 16; i += NWAVES * 64) *(LAS v4u*)(L + HL_SIMG + i * 16) = (v4u){z_, z_, z_, z_}; }
    asm volatile("s_waitcnt vmcnt(0)" ::: "memory"); __syncthreads();
    for (int c = 0; c < NCHUNK; ++c) {
        const int ib = c & 1, vb = HL_V0 + ib * 16384, qb = HL_QH + ib * 16384, kb_ = HL_KH + ib * 16384;
        HG_LANES();
        PT_BEGIN(1)
        if (c + 1 < NCHUNK) HG_DMA(c + 1, (c + 1) & 1);
        u32x2 gw[4]; float g1[2], g2[2], em[2];
        { const bf16* gp = Pb + (size_t)(c * CHUNK + 32 * tb + r) * INW + C_HGT + h * HG_D + 32 * eb + 4 * hh;
#pragma unroll
          for (int g = 0; g < 4; ++g) gw[g] = *(const u32x2*)(gp + 8 * g);
          const int cn = (c + 1 < NCHUNK) ? c + 1 : c;
#pragma unroll
          for (int k2 = 0; k2 < 2; ++k2) { const int d = 32 * (2 * tb + k2) + r; g1[k2] = gvb[(size_t)c * 1536 + d]; g2[k2] = gvb[(size_t)c * 1536 + 512 + d]; em[k2] = gvb[(size_t)cn * 1536 + 1024 + d]; } }
        PT_END(1)
        PT_BEGIN(2)
        f32x16 at[2]; bf16x8 qfr[8];
        { const LAS unsigned char* qp = L + qb + (32 * tb + r) * 256;
#pragma unroll
          for (int ks = 0; ks < 8; ++ks) qfr[ks] = *(const LAS bf16x8*)(qp + (((2 * ks + hh) ^ fx) << 4)); }
#pragma unroll
        for (int sb = 0; sb < 2; ++sb) { if (sb <= tb) { bf16x8 kfr[8];
            const LAS unsigned char* kp = L + kb_ + (32 * sb + r) * 256;
#pragma unroll
            for (int ks = 0; ks < 8; ++ks) kfr[ks] = *(const LAS bf16x8*)(kp + (((2 * ks + hh) ^ fx) << 4));
            __builtin_amdgcn_sched_barrier(0);
#pragma unroll
            for (int j = 0; j < 16; ++j) at[sb][j] = 0.f;
#pragma unroll
            for (int ks = 0; ks < 8; ++ks) at[sb] = MFMA32(kfr[ks], qfr[ks], at[sb]);
            __builtin_amdgcn_sched_barrier(0);
            if (sb == tb) {
#pragma unroll
                for (int j = 0; j < 16; ++j) at[sb][j] = (crow16(j, hh) <= r) ? at[sb][j] : 0.f; } } }
        f32x16 oacc;
#pragma unroll
        for (int j = 0; j < 16; ++j) oacc[j] = 0.f;
        { s16x4 lo[8], hi[8];
#pragma unroll
          for (int ks = 0; ks < 8; ++ks) { const int row0 = 16 * ks + 8 * hh;
              const int ra = row0 + tq, rb = row0 + 4 + tq, ch = 4 * eb + 2 * tbit + (tp >> 1);
              lo[ks] = vtr(L + HL_SIMG + ra * 256 + ((ch ^ offb_key(ra)) << 4) + 8 * (tp & 1)); hi[ks] = vtr(L + HL_SIMG + rb * 256 + ((ch ^ offb_key(rb)) << 4) + 8 * (tp & 1)); }
          __builtin_amdgcn_sched_barrier(0);
#pragma unroll
          for (int ks = 0; ks < 8; ++ks) { const bf16x8 a = {lo[ks][0], lo[ks][1], lo[ks][2], lo[ks][3], hi[ks][0], hi[ks][1], hi[ks][2], hi[ks][3]}; oacc = MFMA32(a, qfr[ks], oacc); }
          __builtin_amdgcn_sched_barrier(0); }
        { s16x4 lo[4], hi[4];
#pragma unroll
          for (int q4 = 0; q4 < 4; ++q4) { if ((q4 >> 1) <= tb) { const int row0 = 32 * (q4 >> 1) + 16 * (q4 & 1) + 4 * hh;
              const int ra = row0 + tq, rb = row0 + 8 + tq, ch = 4 * eb + 2 * tbit + (tp >> 1);
              lo[q4] = vtr(L + vb + ra * 256 + ((ch ^ offb_key(ra)) << 4) + 8 * (tp & 1)); hi[q4] = vtr(L + vb + rb * 256 + ((ch ^ offb_key(rb)) << 4) + 8 * (tp & 1)); } }
          __builtin_amdgcn_sched_barrier(0);
#pragma unroll
          for (int q4 = 0; q4 < 4; ++q4) { if ((q4 >> 1) <= tb) { const bf16x8 a = {lo[q4][0], lo[q4][1], lo[q4][2], lo[q4][3], hi[q4][0], hi[q4][1], hi[q4][2], hi[q4][3]};
              oacc = MFMA32(a, pack8(at[q4 >> 1], q4 & 1), oacc); } }
          __builtin_amdgcn_sched_barrier(0); }
        { float ss = 0.f;
#pragma unroll
          for (int j = 0; j < 16; ++j) ss += oacc[j] * oacc[j];
          ss = pg8::sum_x32(ss);
          if (hh == 0) *(LAS float*)(L + HL_RED + ((tb * 4 + eb) * 32 + r) * 4) = ss; }
        { s16x4 vlo[4], vhi[4], klo[2][4], khi[2][4];
#pragma unroll
          for (int ks = 0; ks < 4; ++ks) { const int row0 = 16 * ks + 8 * hh, ra = row0 + tq, rb = row0 + 4 + tq, ch = 4 * eb + 2 * tbit + (tp >> 1);
              vlo[ks] = vtr(L + vb + ra * 256 + ((ch ^ offb_key(ra)) << 4) + 8 * (tp & 1)); vhi[ks] = vtr(L + vb + rb * 256 + ((ch ^ offb_key(rb)) << 4) + 8 * (tp & 1));
#pragma unroll
              for (int k2 = 0; k2 < 2; ++k2) { const int chk = 4 * (2 * tb + k2) + 2 * tbit + (tp >> 1);
                  klo[k2][ks] = vtr(L + kb_ + ra * 256 + ((chk ^ offb_key(ra)) << 4) + 8 * (tp & 1)); khi[k2][ks] = vtr(L + kb_ + rb * 256 + ((chk ^ offb_key(rb)) << 4) + 8 * (tp & 1)); } }
          __builtin_amdgcn_sched_barrier(0);
#pragma unroll
          for (int k2 = 0; k2 < 2; ++k2) { f32x16 tt;
#pragma unroll
              for (int j = 0; j < 16; ++j) tt[j] = 0.f;
#pragma unroll
              for (int ks = 0; ks < 4; ++ks) { const bf16x8 va = {vlo[ks][0], vlo[ks][1], vlo[ks][2], vlo[ks][3], vhi[ks][0], vhi[ks][1], vhi[ks][2], vhi[ks][3]};
                  const bf16x8 kf = {klo[k2][ks][0], klo[k2][ks][1], klo[k2][ks][2], klo[k2][ks][3], khi[k2][ks][0], khi[k2][ks][1], khi[k2][ks][2], khi[k2][ks][3]};
                  tt = MFMA32(va, kf, tt); }
#pragma unroll
              for (int j = 0; j < 16; ++j) st[k2][j] = g1[k2] * st[k2][j] + g2[k2] * tt[j]; } }
        PT_END(2)
        PT_BEGIN(3)
        asm volatile("s_waitcnt vmcnt(0)" ::: "memory"); __syncthreads(); PT_END(3) PT_BEGIN(4)
        { float ss = 0.f;
#pragma unroll
          for (int k = 0; k < 4; ++k) ss += *(const LAS float*)(L + HL_RED + ((tb * 4 + k) * 32 + r) * 4);
          const float rs = 1.0f / sqrtf(ss * (1.0f / 128.0f) + EPS);
          bf16* op = MIX + ((size_t)b * SEQ + c * CHUNK + 32 * tb + r) * D + h * HG_D + 32 * eb + 4 * hh;
#pragma unroll
          for (int g = 0; g < 4; ++g) { u32x2 w; w.x = cvtpk_c(oacc[4 * g] * rs * bflo(gw[g].x), oacc[4 * g + 1] * rs * bfhi(gw[g].x)); w.y = cvtpk_c(oacc[4 * g + 2] * rs * bflo(gw[g].y), oacc[4 * g + 3] * rs * bfhi(gw[g].y));
              *(u32x2*)(op + 8 * g) = w; } }
        if (c + 1 < NCHUNK) {
#pragma unroll
            for (int k2 = 0; k2 < 2; ++k2) { const int drow = 32 * (2 * tb + k2) + r; const float e_ = em[k2];
#pragma unroll
                for (int g = 0; g < 4; ++g) { u32x2 w; w.x = cvtpk_c(st[k2][4 * g] * e_, st[k2][4 * g + 1] * e_); w.y = cvtpk_c(st[k2][4 * g + 2] * e_, st[k2][4 * g + 3] * e_);
                    *(LAS u32x2*)(L + HL_SIMG + drow * 256 + (((4 * eb + g) ^ fx) << 4) + 8 * hh) = w; } }
        }
        __syncthreads();
        PT_END(4)
    }
#undef HG_LANES
#undef HG_DMA
}
#ifndef WGM_IN
#define WGM_IN 4
#endif
#ifndef WGM_N1K
#define WGM_N1K 4
#endif
#ifndef WGM_FFNUP
#define WGM_FFNUP 4
#endif
#ifndef WGM_MOEUP
#define WGM_MOEUP 4
#endif
#ifndef WGM_MOEDN
#define WGM_MOEDN 4
#endif
#ifndef F8_DENSE_FROM
#define F8_DENSE_FROM 1
#endif
#ifndef SKEW_SKIP
#define SKEW_SKIP 3
#endif
#ifndef STG_N1024
#define STG_N1024 0
#endif
#ifndef STG_FFN
#define STG_FFN 0
#endif
#ifndef STG_MOE
#define STG_MOE 0
#endif

__device__ __forceinline__ void route1(const unsigned char* H, unsigned char* xq, const float* nffn, const float* wr, unsigned* toke, float* tokg, float* tokrs, gu32* cnt, LAS unsigned* lcnt, int w0, int nw, int lane, int tid) {
    if (tid < 16) lcnt[tid] = 0u;
    __syncthreads();
    float wg[16][8];
#pragma unroll
    for (int gq = 0; gq < 2; ++gq) { const int k0 = 8 * (64 * gq + lane);
#pragma unroll
        for (int jj = 0; jj < 8; ++jj) { const float gn = nffn[k0 + jj]; const f32x4 w0v = *(const f32x4*)(wr + (size_t)(k0 + jj) * NE), w1v = *(const f32x4*)(wr + (size_t)(k0 + jj) * NE + 4);
            wg[8 * gq + jj][0] = gn * w0v.x; wg[8 * gq + jj][1] = gn * w0v.y; wg[8 * gq + jj][2] = gn * w0v.z; wg[8 * gq + jj][3] = gn * w0v.w;
            wg[8 * gq + jj][4] = gn * w1v.x; wg[8 * gq + jj][5] = gn * w1v.y; wg[8 * gq + jj][6] = gn * w1v.z; wg[8 * gq + jj][7] = gn * w1v.w; } }
    v4u nh[2], nl[2];
#pragma unroll
    for (int gq = 0; gq < 2; ++gq) { const unsigned char* p = H + (size_t)(w0 < M ? w0 : 0) * 4096 + (64 * gq + lane) * 16; nh[gq] = *(const v4u*)p; nl[gq] = (v4u){0u, 0u, 0u, 0u}; }
    for (int tok = w0; tok < M; tok += nw) {
        float a[8] = {0.f, 0.f, 0.f, 0.f, 0.f, 0.f, 0.f, 0.f}; float ss = 0.f;
        v4u ch[2], cl[2];
#pragma unroll
        for (int gq = 0; gq < 2; ++gq) { ch[gq] = nh[gq]; cl[gq] = nl[gq]; }
        { const int tn = (tok + nw < M) ? tok + nw : tok;
#pragma unroll
          for (int gq = 0; gq < 2; ++gq) { const unsigned char* p = H + (size_t)tn * 4096 + (64 * gq + lane) * 16; nh[gq] = *(const v4u*)p; nl[gq] = (v4u){0u, 0u, 0u, 0u}; } }
#pragma unroll
        for (int gq = 0; gq < 2; ++gq) { const v4u A = ch[gq], C = cl[gq];
            const float hv[8] = {__uint_as_float(A.x << 16) + __uint_as_float(C.x << 16), __uint_as_float(A.x & 0xffff0000u) + __uint_as_float(C.x & 0xffff0000u), __uint_as_float(A.y << 16) + __uint_as_float(C.y << 16), __uint_as_float(A.y & 0xffff0000u) + __uint_as_float(C.y & 0xffff0000u),
                                 __uint_as_float(A.z << 16) + __uint_as_float(C.z << 16), __uint_as_float(A.z & 0xffff0000u) + __uint_as_float(C.z & 0xffff0000u), __uint_as_float(A.w << 16) + __uint_as_float(C.w << 16), __uint_as_float(A.w & 0xffff0000u) + __uint_as_float(C.w & 0xffff0000u)};
#pragma unroll
            for (int jj = 0; jj < 8; ++jj) { const float x = hv[jj]; ss += x * x;
#pragma unroll
                for (int e = 0; e < 8; ++e) a[e] += x * wg[8 * gq + jj][e]; } }
        ss = wave_sum(ss);
#pragma unroll
        for (int e = 0; e < 8; ++e) a[e] = wave_sum(a[e]);
        const float rs = 1.0f / sqrtf(ss * (1.0f / 1024.0f) + EPS);
        int e1 = 0; float l1 = a[0];
#pragma unroll
        for (int e = 1; e < 8; ++e) if (a[e] > l1) { l1 = a[e]; e1 = e; }
        int e2 = -1; float l2 = -3.0e38f;
#pragma unroll
        for (int e = 0; e < 8; ++e) if (e != e1 && a[e] > l2) { l2 = a[e]; e2 = e; }
        const float g1 = 1.0f / (1.0f + __expf((l2 - l1) * rs)), g2 = 1.0f - g1;
#pragma unroll
        for (int gq = 0; gq < 2; ++gq) { const v4u A = ch[gq]; u32x2 w;
            w.x = pg8::pk_fp8x4(__uint_as_float(A.x << 16) * rs, __uint_as_float(A.x & 0xffff0000u) * rs, __uint_as_float(A.y << 16) * rs, __uint_as_float(A.y & 0xffff0000u) * rs);
            w.y = pg8::pk_fp8x4(__uint_as_float(A.z << 16) * rs, __uint_as_float(A.z & 0xffff0000u) * rs, __uint_as_float(A.w << 16) * rs, __uint_as_float(A.w & 0xffff0000u) * rs);
            *(GAS u32x2*)(xq + (size_t)tok * 1024 + (64 * gq + lane) * 8) = w; }
        if (lane == 0) { toke[tok] = (unsigned)e1 | ((unsigned)e2 << 8); tokg[2 * tok] = g1; tokg[2 * tok + 1] = g2; tokrs[tok] = rs;
            __hip_atomic_fetch_add(lcnt + e1, 1u, __ATOMIC_RELAXED, __HIP_MEMORY_SCOPE_WORKGROUP); __hip_atomic_fetch_add(lcnt + 8 + e2, 1u, __ATOMIC_RELAXED, __HIP_MEMORY_SCOPE_WORKGROUP); }
    }
    __syncthreads();
    if (tid < 16) { const unsigned v = lcnt[tid]; if (v) __hip_atomic_fetch_add(cnt + tid, v, RLX_AGENT); }
}
__device__ __forceinline__ void route2(const unsigned* toke, const float* tokg, const float* tokrs, gu32* cnt, gu32* cur, int* row_tok, float* row_gate, float* row_rs, int* tok_row0, LAS unsigned* lw, int wg, int nwg, int tid) {
    const int lane = tid & 63, wave = tid >> 6;
    unsigned pst[2][8];
#pragma unroll
    for (int k = 0; k < 2; ++k) { unsigned acc = 0u;
#pragma unroll
        for (int e = 0; e < 8; ++e) { pst[k][e] = acc; acc += ((__hip_atomic_load(cnt + k * 8 + e, RLX_AGENT) + 255u) >> 8) << 8; } }
    for (int base = wg * 256; base < M; base += nwg * 256) {
        const int tok = base + (tid & 255); unsigned te = 0u; float rs = 0.f; unsigned long long mk[2][8];
        if (wave < 4) { te = toke[tok]; rs = tokrs[tok];
#pragma unroll
            for (int k = 0; k < 2; ++k) { const int e = (int)((te >> (8 * k)) & 255u);
#pragma unroll
                for (int ee = 0; ee < 8; ++ee) { mk[k][ee] = __ballot(e == ee); if (lane == 0) lw[wave * 16 + k * 8 + ee] = (unsigned)__popcll(mk[k][ee]); } } }
        __syncthreads();
        if (tid < 16) { unsigned c0 = lw[tid], c1 = lw[16 + tid], c2 = lw[32 + tid], c3 = lw[48 + tid]; const unsigned tot = c0 + c1 + c2 + c3;
            const unsigned b = tot ? __hip_atomic_fetch_add(cur + tid, tot, RLX_AGENT) : 0u;
            lw[64 + tid] = b; lw[80 + tid] = b + c0; lw[96 + tid] = b + c0 + c1; lw[112 + tid] = b + c0 + c1 + c2; }
        __syncthreads();
        if (wave < 4) {
#pragma unroll
            for (int k = 0; k < 2; ++k) { const int e = (int)((te >> (8 * k)) & 255u); unsigned row = 0u;
#pragma unroll
                for (int ee = 0; ee < 8; ++ee) if (e == ee) row = pst[k][ee] + lw[64 + wave * 16 + k * 8 + ee] + (unsigned)__popcll(mk[k][ee] & ((1ull << lane) - 1ull));
                row_tok[(size_t)k * ROWS_PAD + row] = tok; row_gate[(size_t)k * ROWS_PAD + row] = tokg[2 * tok + k]; row_rs[(size_t)k * ROWS_PAD + row] = rs; if (k == 0) tok_row0[tok] = (int)row; } }
        __syncthreads();
    }
}
__device__ __forceinline__ int moe_panels(gu32* cntk, LAS int* pexp, int tid) {
    int pp = 0, ex = 0;
#pragma unroll
    for (int e = 0; e < 8; ++e) { const int n = (int)((__hip_atomic_load(cntk + e, RLX_AGENT) + 255u) >> 8); if (tid >= pp && tid < pp + n) ex = e; pp += n; }
    if (tid < pp && tid < MAXPANEL) pexp[tid] = ex;
    __syncthreads();
    return pp;
}

#if defined(PROBE_SEC)
#define PT_ARG , pt_acc
#else
#define PT_ARG
#endif
__device__ __forceinline__ void stagger_delay(int bx, int ticks  ) {
    if (ticks > 0 && (bx & 1)) { const unsigned long long t0 = __builtin_amdgcn_s_memrealtime(); while (__builtin_amdgcn_s_memrealtime() - t0 < (unsigned long long)ticks) __builtin_amdgcn_s_sleep(4); }
}
__device__ __forceinline__ void sub_barrier(gu32* cnt, unsigned n, int tid) {
    asm volatile("s_waitcnt vmcnt(0)" ::: "memory");
    __syncthreads();
    if (tid == 0) {
        __builtin_amdgcn_fence(__ATOMIC_RELEASE, "agent");
        asm volatile("s_waitcnt vmcnt(0)" ::: "memory");
        __hip_atomic_fetch_add(cnt, 1u, RLX_AGENT);
        unsigned sp = 0u;
        while (__hip_atomic_load(cnt, RLX_AGENT) < n) { __builtin_amdgcn_s_sleep(2); if (++sp > (1u << 22)) break; }
        __builtin_amdgcn_fence(__ATOMIC_ACQUIRE, "agent");
        asm volatile("s_waitcnt vmcnt(0)" ::: "memory");
    }
    __syncthreads();
}
__global__ void __launch_bounds__(NWAVES * 64, 2) fwd(Args args) {
    extern __shared__ __attribute__((aligned(16))) unsigned char lds[];
    LAS unsigned char* L = (LAS unsigned char*)lds;
    volatile LAS unsigned* MISC = (volatile LAS unsigned*)(L + MISC_OFF);
    { const int t0 = threadIdx.x; for (int u = t0; u < (LDS_BYTES - LDSCTL_OFF) / 4; u += NWAVES * 64) ((LAS unsigned*)(L + LDSCTL_OFF))[u] = 0u; }
    __syncthreads();
    XcdBarrier bar = xcd_barrier_post((unsigned*)((gu32*)(args.ws + WS_CTL)) + CW_BAR, MISC + 8);
    const int lo = args.ph_lo, hi = args.ph_hi; int ph = 0;
    const int wave_s = __builtin_amdgcn_readfirstlane((int)threadIdx.x >> 6);
#if defined(PROBE_SEC)
    unsigned long long pt_acc = 0ull;
#endif
#define PH_BEGIN if (ph >= lo && ph < hi) { int zk_ = 0; asm volatile("" : "+s"(zk_));   unsigned z0_ = 0u; asm volatile("" : "+s"(z0_)); int tid = wave_s * 64 + (int)__builtin_amdgcn_mbcnt_hi(~0u, __builtin_amdgcn_mbcnt_lo(~0u, z0_)); asm volatile("" : "+v"(tid));     GAS unsigned char* wsg_ = (GAS unsigned char*)args.ws; asm volatile("" : "+s"(wsg_)); unsigned char* ws = (unsigned char*)wsg_; \
    int G = gridDim.x; asm volatile("" : "+s"(G)); const int bx = blockIdx.x, vcu = (G % 8 == 0) ? (bx % 8) * (G / 8) + bx / 8 : bx, ngw = G * NWAVES; (void)ngw; \
    const int lane = tid & 63, wave = __builtin_amdgcn_readfirstlane(tid >> 6), gw = vcu * NWAVES + wave; (void)lane; (void)gw; gu32* ctl = (gu32*)(ws + WS_CTL); (void)ctl;
#define PH_END   if (ph + 1 < hi) { XcdBarrier b2_ = bar; GAS unsigned* p2_ = (GAS unsigned*)bar.bar; asm volatile("" : "+s"(p2_)); b2_.bar = (unsigned*)p2_; unsigned z1_ = 0u; asm volatile("" : "+s"(z1_)); xcd_barrier(b2_, wave_s * 64 + (int)__builtin_amdgcn_mbcnt_hi(~0u, __builtin_amdgcn_mbcnt_lo(~0u, z1_))); } } ++ph;
#define TID_FRESH() ({ unsigned zt_ = 0u; asm volatile("" : "+s"(zt_)); int t_ = wave_s * 64 + (int)__builtin_amdgcn_mbcnt_hi(~0u, __builtin_amdgcn_mbcnt_lo(~0u, zt_)); asm volatile("" : "+v"(t_)); t_; })
#define SS   ((float*)(ws + WS_SS))
#define SSM  ((float*)(ws + WS_SSM))
#define MIX  ((bf16*)(ws + WS_MIX))
#define BIG  ((bf16*)(ws + WS_BIG))
#define MB   ((bf16*)(ws + WS_MB))
#define KV   ((bf16*)(ws + WS_KV))
#define OUT  (args.out)
#define STR  ((unsigned char*)args.out)
#define LBT  ((float*)(ws + WS_RT + RT_LB))
#define XQ   (ws + WS_HB)
#define PR_OUT ((args.flags & 4) ? (unsigned char*)(ws + WS_HB) : STR)
#define PR_SS  ((args.flags & 4) ? (float*)(ws + WS_WM + 160 * MiB) : SS)
#define WL   (ws + WS_W + (size_t)l * W_LAYER)
#define WF   (ws + WS_W + W_FFN + (size_t)(l >> 1) * W_FFN_STRIDE)

    PH_BEGIN
    {   LAS unsigned* scr = (LAS unsigned*)(L + wave * 16384); int rot = 0;
        for (int l = 0; l < DEPTH; ++l) {
            cvt_matrix(args.in[(I_WIN) + zk_] + (size_t)l * D * INW, args.in[(I_WIN) + zk_] + (size_t)l * D * INW + 512, D, INW, 1024, (bf16*)(WL + W_IN), args.in[(I_NMIX) + zk_] + l * D, scr, lane, rot, gw, ngw);
            cvt_matrix(args.in[(I_WIN) + zk_] + (size_t)l * D * INW + 1024, nullptr, D, INW, INW - 1024, (bf16*)(WL + W_IN) + (size_t)1024 * D, args.in[(I_NMIX) + zk_] + l * D, scr, lane, rot, gw, ngw);
            cvt_matrix(args.in[(I_WOUT) + zk_] + (size_t)l * D * D, nullptr, D, D, D, (bf16*)(WL + W_OUT), nullptr, scr, lane, rot, gw, ngw);
            cvt_matrix8(args.in[(I_WMQ) + zk_] + (size_t)l * D * D, nullptr, D, D, D, WL + W_MQ, args.in[(I_NMQ) + zk_] + l * D, pg8::F8_WGU, scr, lane, rot, gw, ngw);
            cvt_matrix(args.in[(I_WMKV) + zk_] + (size_t)l * D * 2048, nullptr, D, 2048, 2048, (bf16*)(ws + WS_W + W_KV) + (size_t)l * 2048 * D, args.in[(I_NMKV) + zk_] + l * D, scr, lane, rot, gw, ngw);
            cvt_matrix8(args.in[(I_WMO) + zk_] + (size_t)l * D * D, nullptr, D, D, D, WL + W_MO, nullptr, pg8::F8_WMO, scr, lane, rot, gw, ngw); }
        for (int j = 0; j < 2; ++j) { unsigned char* wfj = ws + WS_W + W_FFN + (size_t)j * W_FFN_STRIDE;
            if (j < F8_DENSE_FROM) {
            cvt_matrix(args.in[(I_WG) + zk_] + (size_t)j * D * FF, args.in[(I_WU) + zk_] + (size_t)j * D * FF, D, FF, 2 * FF, (bf16*)(wfj + W_FFN_GU), args.in[(I_NFFN) + zk_] + (2 * j) * D, scr, lane, rot, gw, ngw);
            cvt_matrix8(args.in[(I_WD) + zk_] + (size_t)j * FF * D, nullptr, FF, D, D, wfj + W_FFN_D, nullptr, pg8::F8_WD, scr, lane, rot, gw, ngw);
            } else {
            cvt_matrix8(args.in[(I_WG) + zk_] + (size_t)j * D * FF, args.in[(I_WU) + zk_] + (size_t)j * D * FF, D, FF, 2 * FF, wfj + W_FFN_GU, args.in[(I_NFFN) + zk_] + (2 * j) * D, pg8::F8_WGU, scr, lane, rot, gw, ngw);
            cvt_matrix8(args.in[(I_WD) + zk_] + (size_t)j * FF * D, nullptr, FF, D, D, wfj + W_FFN_D, nullptr, pg8::F8_WD, scr, lane, rot, gw, ngw); } }
        for (int r0 = gw; r0 < M; r0 += 4 * ngw) {
            f32x4 xa[4][2][2];
#pragma unroll
            for (int q = 0; q < 4; ++q) { const int r = (r0 + q * ngw < M) ? r0 + q * ngw : r0; const float* xr = args.in[(I_X) + zk_] + (size_t)r * D;
#pragma unroll
                for (int gq = 0; gq < 2; ++gq) { xa[q][gq][0] = *(const GAS f32x4*)(xr + 8 * (64 * gq + lane)); xa[q][gq][1] = *(const GAS f32x4*)(xr + 8 * (64 * gq + lane) + 4); } }
#pragma unroll
            for (int q = 0; q < 4; ++q) { const int r = r0 + q * ngw; if (r < M) { float s = 0.f;
#pragma unroll
                for (int gq = 0; gq < 2; ++gq) { const float hv[8] = {xa[q][gq][0].x, xa[q][gq][0].y, xa[q][gq][0].z, xa[q][gq][0].w, xa[q][gq][1].x, xa[q][gq][1].y, xa[q][gq][1].z, xa[q][gq][1].w};
#pragma unroll
                    for (int j = 0; j < 8; ++j) s += hv[j] * hv[j];
                    pg8::hl_store8(STR + (size_t)r * 4096 + (64 * gq + lane) * 16, hv); }
                s = wave_sum(s); if (lane < 16) SS[(size_t)r * 16 + lane] = lane == 0 ? s : 0.f; } } }
        for (int r = gw; r < MROWS; r += ngw) { const float s = row_to_bf16(args.in[(I_MEM) + zk_] + (size_t)r * D, MB + (size_t)r * D, lane); if (lane < 16) SSM[(size_t)r * 16 + lane] = lane == 0 ? s : 0.f; }
        for (int i = gw * 64 + lane; i < HG_W; i += ngw * 64) { const float* lbp = args.in[(I_LB) + zk_] + i; const float a0 = lbp[0], a1 = lbp[512], a2 = lbp[1024], a3 = lbp[1536];
            const float mx = fmaxf(fmaxf(a0, a1), fmaxf(a2, a3)); const float e0 = __expf(a0 - mx), e1 = __expf(a1 - mx), e2 = __expf(a2 - mx), e3 = __expf(a3 - mx); const float inv = 1.0f / (e0 + e1 + e2 + e3);
            LBT[i] = 0.f; LBT[512 + i] = e1 * inv; LBT[1024 + i] = (e1 + e2) * inv; LBT[1536 + i] = (e1 + e2 + e3) * inv; }
    }
    PH_END


    for (int l = 0; l < DEPTH; ++l) {
        PH_BEGIN
        {   pg8::DenseOrderHL S; S.init(M / 256, INW / 256, G, bx, STR, WL + W_IN, D, WGM_IN);
            pg8::EpiInProj E{BIG, INW, SS, LBT + l * HG_W, (float*)(ws + WS_GV), args.in[(I_HGAIN) + zk_] + l * HG_W};
            pg8::gemm_phase<pg8::EpiInProj, pg8::DenseOrderHL, true, true>(L, D, S, E, tid PT_ARG); }
        PH_END
        PH_BEGIN
        {
            if (bx < 64) { if (!(args.flags & 32)) hgrn_phase(BIG, MIX, (const float*)(ws + WS_GV), bx, L, tid PT_ARG); }
            else { if (!(args.flags & 16)) chunk_attn_phase(BIG, MIX, args.in[(I_RELB) + zk_] + (size_t)l * AT_H * NREL, L, tid, bx - 64, G - 64 PT_ARG);
                if (l == 0 && !(args.flags & (16 | 32))) {
                    __syncthreads();
                    pg8::DenseOrder S; S.init(MROWS / 256, DEPTH * 2048 / 256, G - 64, bx - 64, MB, ws + WS_W + W_KV, D);
                    pg8::EpiRowScale E{KV, DEPTH * 2048, SSM, 1.0f, 2};
                    pg8::gemm_phase<pg8::EpiRowScale, pg8::DenseOrder, true, true>(L, D, S, E, TID_FRESH() PT_ARG); }
                if (!(args.flags & (16 | 32))) { const int lm = l | 1, jm = lm >> 1, e0 = (l & 1) * 4; LAS unsigned* scr = (LAS unsigned*)(L + wave * 16384); int rot = 0;
                    const int cw = (bx - 64) * NWAVES + wave, ncw = (G - 64) * NWAVES;
                    for (int e = e0; e < e0 + 4; ++e) { unsigned char* we = ws + WS_WM + (size_t)e * WM_ESTRIDE; const size_t eo = (size_t)(jm * NE + e) * D * FFE;
                        cvt_matrix8(args.in[(I_EG) + zk_] + eo, args.in[(I_EU) + zk_] + eo, D, FFE, 2 * FFE, we + WM_GU, args.in[(I_NFFN) + zk_] + lm * D, pg8::F8_WGU, scr, lane, rot, cw, ncw);
                        cvt_matrix8(args.in[(I_ED) + zk_] + eo, nullptr, FFE, D, D, we + WM_D, nullptr, pg8::F8_WD, scr, lane, rot, cw, ncw); } }
            } }
        PH_END
        PH_BEGIN
        post_rows(MIX, args.in[(I_AGAIN) + zk_] + l * AT_W, gw, ngw, lane);
        PH_END
        PH_BEGIN
        {   pg8::DenseOrder S; S.init(M / 256, D / 256, G, bx, MIX, WL + W_OUT, D, WGM_N1K);
            pg8::EpiResid E{STR, PR_OUT, PR_SS, (args.flags & 4) ? nullptr : XQ, 1.0f};
            pg8::gemm_phase<pg8::EpiResid, pg8::DenseOrder, true, true>(L, D, S, E, tid PT_ARG); }
        PH_END
        PH_BEGIN
        {   pg8::DenseOrder8 S; S.init(M / 256, D / 256, G, bx, XQ, WL + W_MQ, D / 2, WGM_N1K);
            pg8::EpiRowScale E{BIG, D, SS, pg8::F8_Q / pg8::F8_WGU, 1};
            pg8::gemm_phase<pg8::EpiRowScale, pg8::DenseOrder8, true, true>(L, D / 2, S, E, tid PT_ARG); }
        PH_END
        PH_BEGIN
        mem_attn_phase((const unsigned char*)BIG, KV, (unsigned char*)(BIG + (size_t)M * D), l, L, tid, vcu, G PT_ARG);
        PH_END
        PH_BEGIN
        {   pg8::DenseOrder8 S; S.init(M / 256, D / 256, G, bx, BIG + (size_t)M * D, WL + W_MO, D / 2, WGM_N1K);
            pg8::EpiResid E{STR, PR_OUT, PR_SS, ((l & 1) || (l >> 1) < F8_DENSE_FROM || (args.flags & 4)) ? nullptr : XQ, 1.0f / (pg8::F8_O * pg8::F8_WMO)};
            pg8::gemm_phase<pg8::EpiResid, pg8::DenseOrder8, true, true>(L, D / 2, S, E, tid PT_ARG); }
        PH_END
        if ((l & 1) == 0) {
            PH_BEGIN
            if ((l >> 1) < F8_DENSE_FROM) {
                pg8::DenseOrderHL S; S.init(M / 256, 2 * FF / 256, G, bx, STR, WF + W_FFN_GU, D, WGM_FFNUP);
                pg8::EpiSwiglu8<true, false> E{(unsigned char*)BIG, FF, SS};
                pg8::gemm_phase<pg8::EpiSwiglu8<true, false>, pg8::DenseOrderHL, true, true>(L, D, S, E, TID_FRESH() PT_ARG);
            } else {   pg8::DenseOrder8 S; S.init(M / 256, 2 * FF / 256, G, bx, XQ, WF + W_FFN_GU, D / 2, WGM_FFNUP);
                pg8::EpiSwiglu8<true> E{(unsigned char*)BIG, FF, SS};
                pg8::gemm_phase<pg8::EpiSwiglu8<true>, pg8::DenseOrder8, true, true>(L, D / 2, S, E, TID_FRESH() PT_ARG); }
            PH_END
            PH_BEGIN
            {   pg8::DenseOrder8 S; S.init(M / 256, D / 256, G, bx, BIG, WF + W_FFN_D, FF / 2, WGM_N1K);
                pg8::EpiResid E{STR, PR_OUT, PR_SS, nullptr, 1.0f / (pg8::F8_WD * pg8::F8_ACT)};
                pg8::gemm_phase<pg8::EpiResid, pg8::DenseOrder8, true, true>(L, FF / 2, S, E, tid PT_ARG); }
            PH_END
        } else {
            const int j = l >> 1;
#define CNT      (ctl + CW_MOE + j * 64)
#define CUR      (CNT + 32)
#define TOKE     ((unsigned*)(ws + WS_RT + RT_TOKE))
#define TOKG     ((float*)(ws + WS_RT + RT_TOKG))
#define TOKRS    ((float*)(ws + WS_RT + RT_TOKRS))
#define ROW_TOK  ((int*)(ws + WS_RT + RT_ROWTOK))
#define ROW_GATE ((float*)(ws + WS_RT + RT_ROWGATE))
#define ROW_RS   ((float*)(ws + WS_RT + RT_ROWRS))
#define PEXP     ((LAS int*)(L + PEXP_OFF))
#define TOK_ROW0 ((int*)(ws + WS_RT + RT_TOKROW0))
#define Y0BUF    ((bf16*)(ws + WS_MIX))
            PH_BEGIN
            {   if (!(args.flags & 1)) route1(STR, XQ, args.in[(I_NFFN) + zk_] + l * D, args.in[(I_WR) + zk_] + (size_t)j * D * NE, TOKE, TOKG, TOKRS, CNT, (LAS unsigned*)(L + LDSCTL_OFF), gw, ngw, lane, tid);
                for (int i = gw * 64 + lane; i < 2 * ROWS_PAD; i += ngw * 64) ROW_TOK[i] = -1;
            }
            PH_END
            PH_BEGIN
            route2(TOKE, TOKG, TOKRS, CNT, CUR, ROW_TOK, ROW_GATE, ROW_RS, TOK_ROW0, (LAS unsigned*)(L + PEXP_OFF), bx, G, tid);
            PH_END
#define ACT0 ((unsigned char*)(ws + WS_BIG))
#define ACT1 ((unsigned char*)(ws + WS_BIG) + (size_t)ROWS_PAD * FFE)
            PH_BEGIN
            {   const int np = moe_panels(CNT, PEXP, tid);
                pg8::MoeGatherOrder S; S.init(np, 2 * FFE / 256, G, bx, XQ, ws + WS_WM + WM_GU, D / 2, WGM_MOEUP); S.pexp = PEXP; S.e_stride = WM_ESTRIDE; S.row_tok = ROW_TOK;
                pg8::EpiSwiglu8<false> E{ACT0, FFE, nullptr};
                pg8::gemm_phase<pg8::EpiSwiglu8<false>, pg8::MoeGatherOrder, true, true>(L, D / 2, S, E, tid PT_ARG); }
            PH_END
            PH_BEGIN
            {   const int np0 = moe_panels(CNT, PEXP, tid);
                {   pg8::MoeOrder S; S.init(np0, D / 256, G, bx, ACT0, ws + WS_WM + WM_D, FFE / 2, WGM_MOEDN); S.pexp = PEXP; S.e_stride = WM_ESTRIDE;
                    pg8::EpiMoeDown0 E{Y0BUF, ROW_GATE};
                    pg8::gemm_phase<pg8::EpiMoeDown0, pg8::MoeOrder, true, true>(L, FFE / 2, S, E, tid PT_ARG); }
                const int np1 = moe_panels(CNT + 8, PEXP, TID_FRESH());
                {   pg8::MoeGatherOrderSkew S; S.init(np1, 2 * FFE / 256, G, bx, XQ, ws + WS_WM + WM_GU, D / 2, WGM_MOEUP); S.pexp = PEXP; S.e_stride = WM_ESTRIDE; S.row_tok = ROW_TOK + ROWS_PAD;
                    S.nheavy = (np0 * 4) % G; S.skip = SKEW_SKIP;
                    pg8::EpiSwiglu8<false> E{ACT1, FFE, nullptr};
                    pg8::gemm_phase<pg8::EpiSwiglu8<false>, pg8::MoeGatherOrderSkew, true, true>(L, D / 2, S, E, TID_FRESH() PT_ARG); } }
            PH_END
            PH_BEGIN
            {   const int np = moe_panels(CNT + 8, PEXP, tid);
                pg8::MoeOrder S; S.init(np, D / 256, G, bx, ACT1, ws + WS_WM + WM_D, FFE / 2, WGM_MOEDN); S.pexp = PEXP; S.e_stride = WM_ESTRIDE;
                pg8::EpiMoeDown1 E{STR, SS, ROW_TOK + ROWS_PAD, ROW_GATE + ROWS_PAD, Y0BUF, TOK_ROW0};
                pg8::gemm_phase<pg8::EpiMoeDown1, pg8::MoeOrder, true, true>(L, FFE / 2, S, E, tid PT_ARG); }
            PH_END
        }
    }
    PH_BEGIN
    {   const float* ssf = SS; const float* gn = args.in[(I_NFIN) + zk_];
        f32x4 gna[2], gnb[2];
#pragma unroll
        for (int gq = 0; gq < 2; ++gq) { gna[gq] = *(const f32x4*)(gn + 8 * (64 * gq + lane)); gnb[gq] = *(const f32x4*)(gn + 8 * (64 * gq + lane) + 4); }
        for (int r0 = gw; r0 < M; r0 += 2 * ngw) {
            float hv[2][2][8]; float rs[2];
#pragma unroll
            for (int q = 0; q < 2; ++q) { const int r = (r0 + q * ngw < M) ? r0 + q * ngw : r0; rs[q] = 1.0f / sqrtf(pg8::part_sum(ssf, r) * (1.0f / 1024.0f) + EPS);
#pragma unroll
                for (int gq = 0; gq < 2; ++gq) pg8::hl_load8(STR + (size_t)r * 4096 + (64 * gq + lane) * 16, hv[q][gq]); }
            asm volatile("s_waitcnt vmcnt(0)" ::: "memory");
#pragma unroll
            for (int q = 0; q < 2; ++q) { const int r = r0 + q * ngw; if (r < M && (q == 0 || r != r0)) { unsigned char* sr = STR + (size_t)r * 4096;
#pragma unroll
                for (int gq = 0; gq < 2; ++gq) { const int g = 64 * gq + lane; const float s = rs[q];
                    *(f32x4*)(sr + g * 32) = (f32x4){hv[q][gq][0] * s * gna[gq].x, hv[q][gq][1] * s * gna[gq].y, hv[q][gq][2] * s * gna[gq].z, hv[q][gq][3] * s * gna[gq].w};
                    *(f32x4*)(sr + g * 32 + 16) = (f32x4){hv[q][gq][4] * s * gnb[gq].x, hv[q][gq][5] * s * gnb[gq].y, hv[q][gq][6] * s * gnb[gq].z, hv[q][gq][7] * s * gnb[gq].w}; } } } } }
    PH_END
#undef PH_BEGIN
#undef PH_END
#if defined(PROBE_SEC)
    if ((int)blockIdx.x == PROBE_WG) { const unsigned long long t1 = __builtin_amdgcn_s_memrealtime(); while (__builtin_amdgcn_s_memrealtime() - t1 < pt_acc * PROBE_MUL) __builtin_amdgcn_s_sleep(8); }
#endif
}

#ifndef MK_PER_PHASE
#define MK_PER_PHASE 0
#endif
constexpr int N_PHASES = 1 + DEPTH * 7 + (DEPTH / 2) * 2 + (DEPTH / 2) * 5 + 1;
extern "C" void kernel_launch(void* const* d_in, const int* in_sizes, int n_in, void* d_out, int out_size, void* d_ws, size_t ws_size, hipStream_t stream) {
    static int grid = 0;
    if (grid == 0) {
        if (n_in != N_IN || in_sizes[0] != M * D || out_size != M * D || ws_size < WS_END) { fprintf(stderr, "kernel_launch: unexpected shapes / workspace (n_in %d, in0 %d, out %d, ws %zu, need %zu); nothing launched\n", n_in, n_in > 0 ? in_sizes[0] : -1, out_size, ws_size, (size_t)WS_END); grid = -1; return; }
        int dev = 0, cus = 0, per_cu = 0;
        if (hipGetDevice(&dev) != hipSuccess || hipDeviceGetAttribute(&cus, hipDeviceAttributeMultiprocessorCount, dev) != hipSuccess) { grid = -1; return; }
        if (hipFuncSetAttribute((const void*)fwd, hipFuncAttributeMaxDynamicSharedMemorySize, LDS_BYTES) != hipSuccess) { fprintf(stderr, "kernel_launch: hipFuncSetAttribute failed\n"); grid = -1; return; }
        if (hipOccupancyMaxActiveBlocksPerMultiprocessor(&per_cu, (const void*)fwd, NWAVES * 64, LDS_BYTES) != hipSuccess || per_cu < 1) fprintf(stderr, "kernel_launch: occupancy query reports %d workgroups per CU\n", per_cu);
        (void)hipGetLastError();
        grid = cus;
        if (grid < 128) { fprintf(stderr, "kernel_launch: %d CUs: this kernel needs at least 128 workgroups; nothing launched\n", grid); grid = -1; return; }
    }
    if (grid < 0) return;
    if (hipMemsetAsync((char*)d_ws + WS_CTL, 0, CTL_ZERO_BYTES, stream) != hipSuccess) { fprintf(stderr, "kernel_launch: memset failed\n"); return; }
    Args a{};
    for (int i = 0; i < N_IN; ++i) a.in[i] = (const float*)d_in[i];
    a.out = (float*)d_out; a.ws = (unsigned char*)d_ws;
#if MK_PER_PHASE
    for (int p = 0; p < N_PHASES; ++p) { a.ph_lo = p; a.ph_hi = p + 1; hipLaunchKernelGGL(fwd, dim3(grid), dim3(NWAVES * 64), LDS_BYTES, stream, a); }
#else
    a.ph_lo = 0; a.ph_hi = N_PHASES;
    hipLaunchKernelGGL(fwd, dim3(grid), dim3(NWAVES * 64), LDS_BYTES, stream, a);
#endif
#ifdef PROBE_LIST
    { const int plist[] = PROBE_LIST; a.flags = PROBE_FLAGS; for (unsigned i = 0; i < sizeof(plist) / sizeof(int); ++i) { a.ph_lo = plist[i]; a.ph_hi = plist[i] + 1; hipLaunchKernelGGL(fwd, dim3(grid), dim3(NWAVES * 64), LDS_BYTES, stream, a); } }
#endif
    const hipError_t le = hipPeekAtLastError();
    if (le != hipSuccess) fprintf(stderr, "kernel_launch: launch failed: %s\n", hipGetErrorName(le));
}
```

```cpp
#include <hip/hip_runtime.h>
#include <cstdio>
#include <cstdint>

namespace pg8 {
#define PG8_LAS __attribute__((address_space(3)))
typedef unsigned short bf16_t;
typedef short bf16x8 __attribute__((ext_vector_type(8)));
typedef float f32x4 __attribute__((ext_vector_type(4)));
typedef unsigned u32x4 __attribute__((ext_vector_type(4)));
constexpr int BM = 256, BK = 64, HALF = 128, HTB = HALF * BK * 2  , STAGE_BYTES = 8 * HTB, NXCD = 8, WGM = 8;

__host__ __device__ __forceinline__ int lds_byte(int r, int c) { const int st = (r >> 4) * 2 + (c >> 5), rr = r & 15, cc = c & 31, ob = rr * 64 + cc * 2; return st * 1024 + (ob ^ (((ob >> 9) & 1) << 5)); }
__host__ __device__ __forceinline__ void stage_rc(int b, int& R, int& C) { const int st = b / 1024, sb = b % 1024, swz = sb ^ (((sb >> 9) & 1) << 5); R = (st >> 1) * 16 + swz / 64; C = (st & 1) * 32 + (swz % 64) / 2; }
__host__ __device__ __forceinline__ int perm32(int rho) { const int n = rho >> 4, i = rho & 15; return 8 * (i >> 2) + 4 * n + (i & 3); }

struct Unit { int pm, pn; };
struct Gemm { const bf16_t* A; const bf16_t* Bt; int M, N, K; };

struct DenseOrder {
    static constexpr bool GATHER = false, A_HL = false, FP8 = false;
    __device__ __forceinline__ int a_row(const Unit&, int) const { return 0; }
    int nM, nN, nwg, G, c, wgm; const char* A; const char* Bt; size_t a_t, b_t;
    __device__ __forceinline__ void init(int nM_, int nN_, int G_, int c_, const void* A_, const void* Bt_, int K, int wgm_ = 4) { nM = nM_; nN = nN_; nwg = nM * nN; G = G_; c = c_; wgm = wgm_; A = (const char*)A_; Bt = (const char*)Bt_; a_t = (size_t)BM * K * 2; b_t = a_t; }
    __device__ __forceinline__ bool next(int i, Unit& u) const { return next_l((long)i * G + c, u); }
    __device__ __forceinline__ bool next_l(const long L, Unit& u) const {
        if (L >= nwg) return false;
        int wgid = (int)L; { const int q = nwg / NXCD, r = nwg % NXCD, xcd = wgid % NXCD, off = wgid / NXCD; wgid = (xcd < r ? xcd * (q + 1) : r * (q + 1) + (xcd - r) * q) + off; }
        const int nig = wgm * nN, gid = wgid / nig, fm = gid * wgm, gsz = (nM - fm) < wgm ? (nM - fm) : wgm;
        u.pm = fm + ((wgid % nig) % gsz); u.pn = (wgid % nig) / gsz; return true;
    }
    __device__ __forceinline__ const char* a_ptr(const Unit& u) const { return A + (size_t)u.pm * a_t; }
    __device__ __forceinline__ const char* b_ptr(const Unit& u) const { return Bt + (size_t)u.pn * b_t; }
    __device__ __forceinline__ void a_ready(const Unit&) const {}
    __device__ __forceinline__ void done(const Unit&) const {}
};
struct DenseOrder8 : DenseOrder { static constexpr bool FP8 = true; };
struct MoeOrder : DenseOrder {
    static constexpr bool FP8 = true;
    const PG8_LAS int* pexp; size_t e_stride;
    __device__ __forceinline__ const char* b_ptr(const Unit& u) const { return Bt + (size_t)pexp[u.pm] * e_stride + (size_t)u.pn * b_t; }
};

struct DenseOrderHL : DenseOrder {
    static constexpr bool A_HL = true;
    __device__ __forceinline__ void init(int nM_, int nN_, int G_, int c_, const void* A_, const void* Bt_, int K, int wgm_ = 4) { DenseOrder::init(nM_, nN_, G_, c_, A_, Bt_, K, wgm_); a_t = (size_t)BM * 4096; }
};
struct MoeGatherOrder : MoeOrder {
    static constexpr bool GATHER = true, A_HL = false;
    const int* row_tok;
    __device__ __forceinline__ const char* a_ptr(const Unit&) const { return A; }
    __device__ __forceinline__ int a_row(const Unit& u, int R) const { const int t = row_tok[u.pm * BM + R]; return t < 0 ? 0 : t; }
};

struct MoeGatherOrderSkew : MoeGatherOrder {
    int nheavy, skip;
    __device__ __forceinline__ bool next(int i, Unit& u) const {
        const long nl = G - nheavy; long L;
        if (c < nheavy) L = (long)skip * nl + (long)i * G + c;
        else if (i < skip) L = (long)i * nl + (c - nheavy);
        else L = (long)skip * nl + (long)(i - skip) * G + c;
        return next_l(L, u);
    }
};

__device__ __forceinline__ unsigned cvt_pk_bf16(float lo, float hi) { unsigned r; asm volatile("v_cvt_pk_bf16_f32 %0, %1, %2" : "=v"(r) : "v"(lo), "v"(hi)); return r; }
constexpr float RMS_EPS = 1e-6f;
__device__ __forceinline__ float sum_x32(float x) { const auto rr = __builtin_amdgcn_permlane32_swap(__float_as_uint(x), __float_as_uint(x), false, false); return __uint_as_float(rr[0]) + __uint_as_float(rr[1]); }
__device__ __forceinline__ float sum_x16(float x) { const auto rr = __builtin_amdgcn_permlane16_swap(__float_as_uint(x), __float_as_uint(x), false, false); return __uint_as_float(rr[0]) + __uint_as_float(rr[1]); }
__device__ __forceinline__ float max_x32(float x) { const auto rr = __builtin_amdgcn_permlane32_swap(__float_as_uint(x), __float_as_uint(x), false, false); return fmaxf(__uint_as_float(rr[0]), __uint_as_float(rr[1])); }
__device__ __forceinline__ float max_x16(float x) { const auto rr = __builtin_amdgcn_permlane16_swap(__float_as_uint(x), __float_as_uint(x), false, false); return fmaxf(__uint_as_float(rr[0]), __uint_as_float(rr[1])); }
template <int CTRL> __device__ __forceinline__ float dpp_f(float x) { return __uint_as_float((unsigned)__builtin_amdgcn_update_dpp(0, (int)__float_as_uint(x), CTRL, 0xf, 0xf, true)); }
__device__ __forceinline__ float row_sum16(float x) { x += dpp_f<0xB1>(x); x += dpp_f<0x4E>(x); x += dpp_f<0x124>(x); x += dpp_f<0x128>(x); return x; }
__device__ __forceinline__ float row_max16(float x) { x = fmaxf(x, dpp_f<0xB1>(x)); x = fmaxf(x, dpp_f<0x4E>(x)); x = fmaxf(x, dpp_f<0x124>(x)); x = fmaxf(x, dpp_f<0x128>(x)); return x; }
__device__ __forceinline__ float part_sum(const float* part, int r) {
    const f32x4* p = (const f32x4*)(part + (size_t)r * 16); const f32x4 a = p[0], b = p[1], c = p[2], d = p[3];
    return (((a[0] + a[1]) + (a[2] + a[3])) + ((b[0] + b[1]) + (b[2] + b[3]))) + (((c[0] + c[1]) + (c[2] + c[3])) + ((d[0] + d[1]) + (d[2] + d[3])));
}

__device__ __forceinline__ void row_rstd8(const float* ss, int row0, int fq, float (&rs)[2][4]) {
    f32x4 p[2][4];
#pragma unroll
    for (int ai = 0; ai < 2; ++ai)
#pragma unroll
        for (int m = 0; m < 4; ++m) p[ai][m] = *(const f32x4*)(ss + (size_t)(row0 + ai * HALF + m * 16) * 16 + 4 * fq);
#pragma unroll
    for (int ai = 0; ai < 2; ++ai)
#pragma unroll
        for (int m = 0; m < 4; ++m) { const float s = sum_x32(sum_x16((p[ai][m][0] + p[ai][m][1]) + (p[ai][m][2] + p[ai][m][3]))); rs[ai][m] = 1.0f / sqrtf(s * (1.0f / 1024.0f) + RMS_EPS); }
}
constexpr float F8_WGU = 32.0f, F8_WD = 64.0f, F8_ACT = 16.0f, F8_O = 32.0f, F8_WMO = 32.0f, F8_Q = 4.0f, F8_K = 4.0f, F8_V = 4.0f, F8_P = 512.0f;
__device__ __forceinline__ unsigned pk_fp8x4(float a, float b, float c, float d) {
    a = __builtin_amdgcn_fmed3f(a, -448.0f, 448.0f); b = __builtin_amdgcn_fmed3f(b, -448.0f, 448.0f); c = __builtin_amdgcn_fmed3f(c, -448.0f, 448.0f); d = __builtin_amdgcn_fmed3f(d, -448.0f, 448.0f);
    int p = __builtin_amdgcn_cvt_pk_fp8_f32(a, b, 0, false); p = __builtin_amdgcn_cvt_pk_fp8_f32(c, d, p, true); return (unsigned)p;
}
struct EpiRowScale {
    static constexpr int PID = 1;
    static constexpr bool PERM = true, AFTER_DRAIN = false;
    bf16_t* O; int ldc; const float* ss; float sc; int mode;
    __device__ __forceinline__ void operator()(const f32x4 (&acc)[2][2][4][2], const Unit& u, int wr, int wc, int fr, int fq) const {
        const int row0 = u.pm * BM + wr * 64 + fr, col0 = u.pn * BM + wc * 32 + 8 * fq;
        float rs[2][4]; row_rstd8(ss, row0, fq, rs);
#pragma unroll
        for (int ai = 0; ai < 2; ++ai)
#pragma unroll
            for (int m = 0; m < 4; ++m) { const int r = row0 + ai * HALF + m * 16; const float s = rs[ai][m] * sc;
                bf16_t* rowp = O + (size_t)r * ldc + col0;
                const bool k8 = mode == 2 && (u.pn & 7) < 4;
                if (mode == 1 || k8) { typedef unsigned u32x2_ __attribute__((ext_vector_type(2)));
                    unsigned char* rp8 = mode == 1 ? (unsigned char*)O + (size_t)r * ldc + col0 : (unsigned char*)O + (size_t)r * ldc * 2 + (u.pn >> 3) * 4096 + (u.pn & 3) * BM + wc * 32 + 8 * fq;
                    const float s8 = mode == 1 ? s : s * F8_K;
#pragma unroll
                    for (int bj = 0; bj < 2; ++bj) { const f32x4 v0 = acc[ai][bj][m][0] * s8, v1 = acc[ai][bj][m][1] * s8;
                        u32x2_ w; w.x = pk_fp8x4(v0[0], v0[1], v0[2], v0[3]); w.y = pk_fp8x4(v1[0], v1[1], v1[2], v1[3]); *(u32x2_*)(rp8 + bj * HALF) = w; }
                } else {
#pragma unroll
                for (int bj = 0; bj < 2; ++bj) { const f32x4 v0 = acc[ai][bj][m][0] * s, v1 = acc[ai][bj][m][1] * s;
                    u32x4 w; w.x = cvt_pk_bf16(v0[0], v0[1]); w.y = cvt_pk_bf16(v0[2], v0[3]); w.z = cvt_pk_bf16(v1[0], v1[1]); w.w = cvt_pk_bf16(v1[2], v1[3]);
                    *(u32x4*)(rowp + bj * HALF) = w; } } }
    }
};
struct EpiInProj {
    static constexpr int PID = 5;
    static constexpr bool PERM = true, AFTER_DRAIN = false;
    bf16_t* O; int ldc; const float* ss; const float* lb; float* gv; const float* hgain;
    __device__ __forceinline__ void operator()(const f32x4 (&acc_)[2][2][4][2], const Unit& u, int wr, int wc, int fr_, int fq_) const {
        f32x4 (&acc)[2][2][4][2] = const_cast<f32x4 (&)[2][2][4][2]>(acc_);
        int fr = fr_, fq = fq_; asm volatile("" : "+v"(fr), "+v"(fq));
        const int row0 = u.pm * BM + wr * 64 + fr, col0 = u.pn * BM + wc * 32 + 8 * fq;
        const float L2E = 1.4426950408889634f;
        float rs8[2][4]; row_rstd8(ss, row0, fq, rs8);
#pragma unroll
        for (int ai = 0; ai < 2; ++ai) {
            float rs[4];
#pragma unroll
            for (int m = 0; m < 4; ++m) rs[m] = rs8[ai][m];
            if (u.pn < 4) {
                const int d0 = wc * 32 + 8 * fq, chunk = u.pm * 4 + ai * 2 + wr;
#pragma unroll
                for (int n = 0; n < 2; ++n) { const f32x4 lb4 = *(const f32x4*)(lb + u.pn * 128 + d0 + 4 * n);
#pragma unroll
                    for (int j = 0; j < 4; ++j) { const float lbv = lb4[j]; float bb[4]; float pre = 0.f, bm = 0.f;
#pragma unroll
                        for (int m = 0; m < 4; ++m) { const float x = acc[ai][1][m][n][j] * rs[m]; const float f = lbv + (1.0f - lbv) * __builtin_amdgcn_rcpf(1.0f + __builtin_amdgcn_exp2f(-L2E * x));
                            float l2 = __builtin_amdgcn_logf(f); asm volatile("" : "+v"(l2));     acc[ai][1][m][n][j] = 1.0f - f;
                            float s = l2; s += dpp_f<0x111>(s); s += dpp_f<0x112>(s); s += dpp_f<0x114>(s); s += dpp_f<0x118>(s);
                            bb[m] = pre + s; pre += row_sum16(l2); if (m == 1) bm = pre; }
                        const float be = pre;
#pragma unroll
                        for (int m = 0; m < 4; ++m) { const float dd = bb[m] - bm; acc[ai][0][m][n][j] = acc[ai][0][m][n][j] * rs[m] * __builtin_amdgcn_exp2f(dd); acc[ai][1][m][n][j] *= __builtin_amdgcn_exp2f(-dd); }
                        if (fr == 0) { float* gp = gv + (size_t)chunk * 1536 + u.pn * 128 + d0 + 4 * n + j; gp[0] = __builtin_amdgcn_exp2f(be); gp[512] = __builtin_amdgcn_exp2f(be - bm); gp[1024] = __builtin_amdgcn_exp2f(bm); }
                        __builtin_amdgcn_sched_barrier(0); }
                }
#pragma unroll
                for (int m = 0; m < 4; ++m) rs[m] = 1.0f;
            }
#pragma unroll
            for (int m = 0; m < 4; ++m) { bf16_t* rowp = O + (size_t)(row0 + ai * HALF + m * 16) * ldc + col0; const float s = rs[m];
#pragma unroll
                for (int bj = 0; bj < 2; ++bj) { f32x4 v0 = acc[ai][bj][m][0] * s, v1 = acc[ai][bj][m][1] * s;
                    if (u.pn == 6 || u.pn == 7) {
                        const float* gq = hgain + (u.pn - 6) * BM + bj * HALF + wc * 32 + 8 * fq; const f32x4 ga = *(const f32x4*)gq, gb = *(const f32x4*)(gq + 4);
#pragma unroll
                        for (int j = 0; j < 4; ++j) { v0[j] = v0[j] * ga[j] * __builtin_amdgcn_rcpf(1.0f + __builtin_amdgcn_exp2f(-L2E * v0[j])); v1[j] = v1[j] * gb[j] * __builtin_amdgcn_rcpf(1.0f + __builtin_amdgcn_exp2f(-L2E * v1[j])); } }
                    u32x4 w; w.x = cvt_pk_bf16(v0[0], v0[1]); w.y = cvt_pk_bf16(v0[2], v0[3]); w.z = cvt_pk_bf16(v1[0], v1[1]); w.w = cvt_pk_bf16(v1[2], v1[3]);
                    *(u32x4*)(rowp + bj * HALF) = w; } }
            asm volatile("" ::: "memory"); __builtin_amdgcn_sched_barrier(0);
        }
    }
};
__device__ __forceinline__ void hl_load8(const unsigned char* p, float (&h)[8]) {
    const u32x4 a = *(const u32x4*)p;
    h[0] = __uint_as_float(a.x << 16); h[1] = __uint_as_float(a.x & 0xffff0000u); h[2] = __uint_as_float(a.y << 16); h[3] = __uint_as_float(a.y & 0xffff0000u);
    h[4] = __uint_as_float(a.z << 16); h[5] = __uint_as_float(a.z & 0xffff0000u); h[6] = __uint_as_float(a.w << 16); h[7] = __uint_as_float(a.w & 0xffff0000u);
}
__device__ __forceinline__ void hl_store8(unsigned char* p, const float (&h)[8]) {
    u32x4 a; a.x = cvt_pk_bf16(h[0], h[1]); a.y = cvt_pk_bf16(h[2], h[3]); a.z = cvt_pk_bf16(h[4], h[5]); a.w = cvt_pk_bf16(h[6], h[7]);
    *(u32x4*)p = a;
}
struct EpiResid {
    static constexpr int PID = 2;
    static constexpr bool PERM = true, AFTER_DRAIN = false;
    const unsigned char* base; unsigned char* out; float* ssn; unsigned char* xq; float sc;
    __device__ __forceinline__ void operator()(const f32x4 (&acc)[2][2][4][2], const Unit& u, int wr, int wc, int fr_, int fq_) const {
        (void)fr_; (void)fq_; unsigned z_ = 0u; asm volatile("" : "+s"(z_)); const int ln_ = (int)__builtin_amdgcn_mbcnt_hi(~0u, __builtin_amdgcn_mbcnt_lo(~0u, z_)), fr = ln_ & 15, fq = ln_ >> 4;
        const int row0 = u.pm * BM + wr * 64 + fr, g0 = u.pn * 32 + wc * 4 + fq;
        u32x4 ra[2][4][2];
#pragma unroll
        for (int ai = 0; ai < 2; ++ai)
#pragma unroll
            for (int m = 0; m < 4; ++m)
#pragma unroll
                for (int bj = 0; bj < 2; ++bj) ra[ai][m][bj] = *(const u32x4*)(base + (size_t)(row0 + ai * HALF + m * 16) * 4096 + (g0 + 16 * bj) * 16);
        asm volatile("" ::: "memory");
#pragma unroll
        for (int ai = 0; ai < 2; ++ai)
#pragma unroll
            for (int m = 0; m < 4; ++m) { const int r = row0 + ai * HALF + m * 16; float q = 0.f;
#pragma unroll
                for (int bj = 0; bj < 2; ++bj) { const u32x4 a = ra[ai][m][bj]; float h[8];
                    h[0] = __uint_as_float(a.x << 16) + sc * acc[ai][bj][m][0][0]; h[1] = __uint_as_float(a.x & 0xffff0000u) + sc * acc[ai][bj][m][0][1]; h[2] = __uint_as_float(a.y << 16) + sc * acc[ai][bj][m][0][2]; h[3] = __uint_as_float(a.y & 0xffff0000u) + sc * acc[ai][bj][m][0][3];
                    h[4] = __uint_as_float(a.z << 16) + sc * acc[ai][bj][m][1][0]; h[5] = __uint_as_float(a.z & 0xffff0000u) + sc * acc[ai][bj][m][1][1]; h[6] = __uint_as_float(a.w << 16) + sc * acc[ai][bj][m][1][2]; h[7] = __uint_as_float(a.w & 0xffff0000u) + sc * acc[ai][bj][m][1][3];
                    u32x4 o; o.x = cvt_pk_bf16(h[0], h[1]); o.y = cvt_pk_bf16(h[2], h[3]); o.z = cvt_pk_bf16(h[4], h[5]); o.w = cvt_pk_bf16(h[6], h[7]);
                    if (xq) { typedef unsigned u32x2_ __attribute__((ext_vector_type(2))); u32x2_ w8; w8.x = pk_fp8x4(h[0], h[1], h[2], h[3]); w8.y = pk_fp8x4(h[4], h[5], h[6], h[7]); *(u32x2_*)(xq + (size_t)r * 1024 + (g0 + 16 * bj) * 8) = w8; }
                    const float s0 = __uint_as_float(o.x << 16), s1 = __uint_as_float(o.x & 0xffff0000u), s2 = __uint_as_float(o.y << 16), s3 = __uint_as_float(o.y & 0xffff0000u), s4 = __uint_as_float(o.z << 16), s5 = __uint_as_float(o.z & 0xffff0000u), s6 = __uint_as_float(o.w << 16), s7 = __uint_as_float(o.w & 0xffff0000u);
                    q += ((s0 * s0 + s1 * s1) + (s2 * s2 + s3 * s3)) + ((s4 * s4 + s5 * s5) + (s6 * s6 + s7 * s7));
                    *(u32x4*)(out + (size_t)r * 4096 + (g0 + 16 * bj) * 16) = o; }
                q = sum_x32(sum_x16(q));
                if (fq == 0) ssn[(size_t)r * 16 + u.pn * 4 + wc] = q; }
    }
};
template <bool RS_DIRECT> struct EpiSwiglu {
    static constexpr int PID = 3;
    static constexpr bool PERM = true, AFTER_DRAIN = false;
    bf16_t* O; int ldc; const float* ss;
    __device__ __forceinline__ void operator()(const f32x4 (&acc)[2][2][4][2], const Unit& u, int wr, int wc, int fr, int fq) const {
        const int row0 = u.pm * BM + wr * 64 + fr, col0 = u.pn * HALF + wc * 32 + 8 * fq;
        float rs[2][4];
        if (RS_DIRECT) {
#pragma unroll
            for (int ai = 0; ai < 2; ++ai)
#pragma unroll
                for (int m = 0; m < 4; ++m) rs[ai][m] = ss[row0 + ai * HALF + m * 16];
        } else row_rstd8(ss, row0, fq, rs);
#pragma unroll
        for (int ai = 0; ai < 2; ++ai)
#pragma unroll
            for (int m = 0; m < 4; ++m) { const int r = row0 + ai * HALF + m * 16; const float s = rs[ai][m];
                float a[8];
#pragma unroll
                for (int n = 0; n < 2; ++n)
#pragma unroll
                    for (int j2 = 0; j2 < 2; ++j2) { typedef float f2 __attribute__((ext_vector_type(2)));
                        const f2 g = (f2){acc[ai][0][m][n][2 * j2], acc[ai][0][m][n][2 * j2 + 1]} * s, up = (f2){acc[ai][1][m][n][2 * j2], acc[ai][1][m][n][2 * j2 + 1]} * s;
                        const f2 t = g * (-1.4426950408889634f); f2 e; e.x = __builtin_amdgcn_exp2f(t.x); e.y = __builtin_amdgcn_exp2f(t.y);
                        const f2 d = e + 1.0f; f2 rc; rc.x = __builtin_amdgcn_rcpf(d.x); rc.y = __builtin_amdgcn_rcpf(d.y);
                        const f2 o = (g * up) * rc; a[n * 4 + 2 * j2] = o.x; a[n * 4 + 2 * j2 + 1] = o.y; }
                u32x4 w; w.x = cvt_pk_bf16(a[0], a[1]); w.y = cvt_pk_bf16(a[2], a[3]); w.z = cvt_pk_bf16(a[4], a[5]); w.w = cvt_pk_bf16(a[6], a[7]);
                *(u32x4*)(O + (size_t)r * ldc + col0) = w; }
    }
};
template <bool ROWRS, bool W8 = true> struct EpiSwiglu8 {
    static constexpr int PID = 3;
    static constexpr bool PERM = true, AFTER_DRAIN = false;
    unsigned char* O; int ldc; const float* ss;
    __device__ __forceinline__ void operator()(const f32x4 (&acc)[2][2][4][2], const Unit& u, int wr, int wc, int fr, int fq) const {
        const int row0 = u.pm * BM + wr * 64 + fr, col0 = u.pn * HALF + wc * 32 + 8 * fq;
        float rs[2][4];
        if constexpr (ROWRS) row_rstd8(ss, row0, fq, rs);
#pragma unroll
        for (int ai = 0; ai < 2; ++ai)
#pragma unroll
            for (int m = 0; m < 4; ++m) { const int r = row0 + ai * HALF + m * 16;
                const float wsc = W8 ? 1.0f / F8_WGU : 1.0f, sg = ROWRS ? rs[ai][m] * wsc : wsc, su = sg * F8_ACT;
                float a[8];
#pragma unroll
                for (int n = 0; n < 2; ++n)
#pragma unroll
                    for (int j2 = 0; j2 < 2; ++j2) { typedef float f2 __attribute__((ext_vector_type(2)));
                        const f2 g = (f2){acc[ai][0][m][n][2 * j2], acc[ai][0][m][n][2 * j2 + 1]} * sg, up = (f2){acc[ai][1][m][n][2 * j2], acc[ai][1][m][n][2 * j2 + 1]} * su;
                        const f2 t = g * (-1.4426950408889634f); f2 e; e.x = __builtin_amdgcn_exp2f(t.x); e.y = __builtin_amdgcn_exp2f(t.y);
                        const f2 d = e + 1.0f; f2 rc; rc.x = __builtin_amdgcn_rcpf(d.x); rc.y = __builtin_amdgcn_rcpf(d.y);
                        const f2 o = (g * up) * rc; a[n * 4 + 2 * j2] = o.x; a[n * 4 + 2 * j2 + 1] = o.y; }
                typedef unsigned u32x2_ __attribute__((ext_vector_type(2)));
                u32x2_ w; w.x = pk_fp8x4(a[0], a[1], a[2], a[3]); w.y = pk_fp8x4(a[4], a[5], a[6], a[7]);
                *(u32x2_*)(O + (size_t)r * ldc + col0) = w; }
    }
};
struct EpiMoeDown0 {
    static constexpr int PID = 4;
    static constexpr bool PERM = true, AFTER_DRAIN = false;
    bf16_t* y0; const float* row_gate;
    __device__ __forceinline__ void operator()(const f32x4 (&acc)[2][2][4][2], const Unit& u, int wr, int wc, int fr, int fq) const {
        const int row0 = u.pm * BM + wr * 64 + fr, col0 = u.pn * BM + wc * 32 + 8 * fq;
        float gt[2][4];
#pragma unroll
        for (int ai = 0; ai < 2; ++ai)
#pragma unroll
            for (int m = 0; m < 4; ++m) gt[ai][m] = row_gate[row0 + ai * HALF + m * 16] * (1.0f / (F8_WD * F8_ACT));
#pragma unroll
        for (int ai = 0; ai < 2; ++ai)
#pragma unroll
            for (int m = 0; m < 4; ++m) { bf16_t* rowp = y0 + (size_t)(row0 + ai * HALF + m * 16) * 1024 + col0; const float s = gt[ai][m];
#pragma unroll
                for (int bj = 0; bj < 2; ++bj) { const f32x4 v0 = acc[ai][bj][m][0] * s, v1 = acc[ai][bj][m][1] * s;
                    u32x4 w; w.x = cvt_pk_bf16(v0[0], v0[1]); w.y = cvt_pk_bf16(v0[2], v0[3]); w.z = cvt_pk_bf16(v1[0], v1[1]); w.w = cvt_pk_bf16(v1[2], v1[3]);
                    *(u32x4*)(rowp + bj * HALF) = w; } }
    }
};
struct EpiMoeDown1 {
    static constexpr int PID = 4;
    static constexpr bool PERM = true, AFTER_DRAIN = false;
    unsigned char* h; float* ssn; const int* row_tok; const float* row_gate; const bf16_t* y0; const int* tok_row0;
    __device__ __forceinline__ void operator()(const f32x4 (&acc)[2][2][4][2], const Unit& u, int wr, int wc, int fr, int fq) const {
        const int row0 = u.pm * BM + wr * 64 + fr, g0 = u.pn * 32 + wc * 4 + fq;
#pragma unroll
        for (int ai = 0; ai < 2; ++ai) {
            u32x4 ra[4][2], ry[4][2]; int tk[4]; float gt[4];
#pragma unroll
            for (int m = 0; m < 4; ++m) { const int r = row0 + ai * HALF + m * 16; tk[m] = row_tok[r]; gt[m] = row_gate[r] * (1.0f / (F8_WD * F8_ACT)); }
#pragma unroll
            for (int m = 0; m < 4; ++m) { const int tc = tk[m] < 0 ? 0 : tk[m]; const int r0 = tok_row0[tc];
#pragma unroll
                for (int bj = 0; bj < 2; ++bj) { ra[m][bj] = *(const u32x4*)(h + (size_t)tc * 4096 + (g0 + 16 * bj) * 16); ry[m][bj] = *(const u32x4*)(y0 + (size_t)r0 * 1024 + (g0 + 16 * bj) * 8); } }
            asm volatile("" ::: "memory");
#pragma unroll
            for (int m = 0; m < 4; ++m) { const int tok = tk[m]; const float g = gt[m]; float q = 0.f;
                if (tok >= 0) {
#pragma unroll
                    for (int bj = 0; bj < 2; ++bj) { const u32x4 a = ra[m][bj], y = ry[m][bj]; float v[8];
                        v[0] = __uint_as_float(a.x << 16) + (__uint_as_float(y.x << 16) + g * acc[ai][bj][m][0][0]); v[1] = __uint_as_float(a.x & 0xffff0000u) + (__uint_as_float(y.x & 0xffff0000u) + g * acc[ai][bj][m][0][1]);
                        v[2] = __uint_as_float(a.y << 16) + (__uint_as_float(y.y << 16) + g * acc[ai][bj][m][0][2]); v[3] = __uint_as_float(a.y & 0xffff0000u) + (__uint_as_float(y.y & 0xffff0000u) + g * acc[ai][bj][m][0][3]);
                        v[4] = __uint_as_float(a.z << 16) + (__uint_as_float(y.z << 16) + g * acc[ai][bj][m][1][0]); v[5] = __uint_as_float(a.z & 0xffff0000u) + (__uint_as_float(y.z & 0xffff0000u) + g * acc[ai][bj][m][1][1]);
                        v[6] = __uint_as_float(a.w << 16) + (__uint_as_float(y.w << 16) + g * acc[ai][bj][m][1][2]); v[7] = __uint_as_float(a.w & 0xffff0000u) + (__uint_as_float(y.w & 0xffff0000u) + g * acc[ai][bj][m][1][3]);
                        u32x4 o; o.x = cvt_pk_bf16(v[0], v[1]); o.y = cvt_pk_bf16(v[2], v[3]); o.z = cvt_pk_bf16(v[4], v[5]); o.w = cvt_pk_bf16(v[6], v[7]);
                        const float s0 = __uint_as_float(o.x << 16), s1 = __uint_as_float(o.x & 0xffff0000u), s2 = __uint_as_float(o.y << 16), s3 = __uint_as_float(o.y & 0xffff0000u), s4 = __uint_as_float(o.z << 16), s5 = __uint_as_float(o.z & 0xffff0000u), s6 = __uint_as_float(o.w << 16), s7 = __uint_as_float(o.w & 0xffff0000u);
                        q += ((s0 * s0 + s1 * s1) + (s2 * s2 + s3 * s3)) + ((s4 * s4 + s5 * s5) + (s6 * s6 + s7 * s7));
                        *(u32x4*)(h + (size_t)tok * 4096 + (g0 + 16 * bj) * 16) = o; } }
                q = sum_x32(sum_x16(q)); if (fq == 0 && tok >= 0) ssn[(size_t)tok * 16 + u.pn * 4 + wc] = q; }
            asm volatile("" ::: "memory"); }
    }
};

typedef int i32x8 __attribute__((ext_vector_type(8)));
typedef short bf16x16 __attribute__((ext_vector_type(16)));
__device__ __forceinline__ f32x4 mfma_fp8_k128(bf16x8 b0, bf16x8 b1, bf16x8 a0, bf16x8 a1, f32x4 c) {
    const bf16x16 B = __builtin_shufflevector(b0, b1, 0, 1, 2, 3, 4, 5, 6, 7, 8, 9, 10, 11, 12, 13, 14, 15), A = __builtin_shufflevector(a0, a1, 0, 1, 2, 3, 4, 5, 6, 7, 8, 9, 10, 11, 12, 13, 14, 15);
    const i32x8 Bi = __builtin_bit_cast(i32x8, B), Ai = __builtin_bit_cast(i32x8, A);
    asm volatile("v_mfma_f32_16x16x128_f8f6f4 %0, %1, %2, %0" : "+v"(c) : "v"(Bi), "v"(Ai));
    return c;
}
template <class Epi, class Sched, bool ALIGN_EPI = false, bool SP2 = false>
__device__ __forceinline__ void gemm_phase(PG8_LAS unsigned char* lds, const int K, const Sched& S, const Epi& E, const int tid_in
#if defined(PROBE_SEC)
    , unsigned long long& pt_acc
#endif
    ) {
    int tid_o = tid_in; asm volatile("" : "+v"(tid_o));
    const int tid = tid_o, wid = __builtin_amdgcn_readfirstlane(tid >> 6), lane = tid & 63, wr = wid >> 2, wc = wid & 3, fr = lane & 15, fq = lane >> 4;
    const int nt = K / BK;
    unsigned voffA[2], voffB[2];
#pragma unroll
    for (int i = 0; i < 2; ++i) { int R, C; stage_rc(tid * 16 + i * 8192, R, C); const int Rb = Epi::PERM ? ((R & ~31) + perm32(R & 31)) : R;
        voffA[i] = Sched::A_HL ? (unsigned)(R * 4096 + C * 2) : (unsigned)(R * K + C) * 2u; voffB[i] = (unsigned)(Rb * K + C) * 2u; }
    unsigned gcur[2][2] = {{0u, 0u}, {0u, 0u}}, gnxt[2][2] = {{0u, 0u}, {0u, 0u}};
#define PG8_GOFF(dst, u) do { if constexpr (Sched::GATHER) { _Pragma("unroll") for (int _h = 0; _h < 2; ++_h) _Pragma("unroll") for (int _i = 0; _i < 2; ++_i) { int R_, C_; stage_rc(tid * 16 + _i * 8192, R_, C_); \
        dst[_h][_i] = Sched::A_HL ? (unsigned)S.a_row(u, _h * HALF + R_) * 4096u + (unsigned)(C_ * 2) : (unsigned)S.a_row(u, _h * HALF + R_) * (unsigned)(K * 2) + (unsigned)(C_ * 2); } } } while (0)
    const size_t kstepA = (size_t)(BK * 2), hstepA = Sched::A_HL ? (size_t)HALF * 4096 : (size_t)HALF * K * 2;
    const size_t kstep = (size_t)(BK * 2);
    const size_t hstep = (size_t)HALF * K * 2;
    const size_t tstep = 2 * hstep;
    const unsigned ldsw = (unsigned)wid * 1024u;
    const int aoff = lds_byte(wr * 64 + fr, fq * 8), boff = lds_byte(wc * 32 + fr, fq * 8);
#define PG8_SA(b, h) (((b) * 2 + (h)) * HTB)
#define PG8_SB(b, h) ((4 + (b) * 2 + (h)) * HTB)
#define PG8_STAGE(bufoff, gbase, voff) do { _Pragma("unroll") for (int _i = 0; _i < 2; ++_i) \
        __builtin_amdgcn_global_load_lds((const unsigned*)((const char*)(gbase) + (voff)[_i]), (PG8_LAS unsigned*)(lds + (bufoff) + ldsw + _i * 8192), 16, 0, 0); } while (0)
#define PG8_STAGE_A(bufoff, aptr, H, GO) do { _Pragma("unroll") for (int _i = 0; _i < 2; ++_i) \
        __builtin_amdgcn_global_load_lds((const unsigned*)((const char*)(aptr) + (Sched::GATHER ? GO[H][_i] : voffA[_i] + (unsigned)((H) * hstepA))), (PG8_LAS unsigned*)(lds + (bufoff) + ldsw + _i * 8192), 16, 0, 0); } while (0)
#define PG8_LDA(dst, b, h) do { _Pragma("unroll") for (int m = 0; m < 4; ++m) _Pragma("unroll") for (int k = 0; k < 2; ++k) dst[m][k] = *(const PG8_LAS bf16x8*)(lds + PG8_SA(b, h) + aoff + m * 2048 + k * 1024); } while (0)
#define PG8_LDB(dst, b, h) do { _Pragma("unroll") for (int n = 0; n < 2; ++n) _Pragma("unroll") for (int k = 0; k < 2; ++k) dst[n][k] = *(const PG8_LAS bf16x8*)(lds + PG8_SB(b, h) + boff + n * 2048 + k * 1024); } while (0)
#define PG8_MMA(ai, bj, At, Bt) do { __builtin_amdgcn_s_setprio(1); _Pragma("unroll") for (int m = 0; m < 4; ++m) _Pragma("unroll") for (int n = 0; n < 2; ++n) { \
        if constexpr (Sched::FP8) acc[ai][bj][m][n] = mfma_fp8_k128(Bt[n][0], Bt[n][1], At[m][0], At[m][1], acc[ai][bj][m][n]); \
        else { _Pragma("unroll") for (int k = 0; k < 2; ++k) acc[ai][bj][m][n] = __builtin_amdgcn_mfma_f32_16x16x32_bf16(Bt[n][k], At[m][k], acc[ai][bj][m][n], 0, 0, 0); } } __builtin_amdgcn_s_setprio(0); } while (0)
#define PG8_WAIT_V(n) asm volatile("s_waitcnt vmcnt(" #n ")" ::: "memory")
#define PG8_WAIT_L(n) asm volatile("s_waitcnt lgkmcnt(" #n ")" ::: "memory")
#define PG8_BAR __builtin_amdgcn_s_barrier()
#define PG8_SCHED __builtin_amdgcn_sched_barrier(0)
    Unit cur, nxt; int ui = 0;
    if (!S.next(0, cur)) return;
    f32x4 acc[2][2][4][2];
#pragma unroll
    for (int a = 0; a < 2; ++a)
#pragma unroll
        for (int b = 0; b < 2; ++b)
#pragma unroll
            for (int m = 0; m < 4; ++m)
#pragma unroll
                for (int n = 0; n < 2; ++n) { acc[a][b][m][n] = (f32x4){0.f, 0.f, 0.f, 0.f}; if constexpr (Sched::FP8) asm volatile("" : "+v"(acc[a][b][m][n])); }
    bf16x8 At[4][2], B0[2][2], B1[2][2];
    const char* cA = S.a_ptr(cur); const char* cB = S.b_ptr(cur);
    PG8_GOFF(gcur, cur);
    S.a_ready(cur);
    if constexpr (SP2) {
        PG8_STAGE(PG8_SB(0, 0), cB, voffB); PG8_STAGE(PG8_SB(0, 1), cB + hstep, voffB); PG8_STAGE_A(PG8_SA(0, 0), cA, 0, gcur); PG8_STAGE_A(PG8_SA(0, 1), cA, 1, gcur);
        if (wr == 1) PG8_BAR;
        PG8_WAIT_V(2); PG8_BAR;
        PG8_STAGE(PG8_SB(1, 0), cB + kstep, voffB); PG8_STAGE_A(PG8_SA(1, 0), cA + kstepA, 0, gcur); PG8_STAGE(PG8_SB(1, 1), cB + hstep + kstep, voffB);
        PG8_WAIT_V(6); PG8_BAR;
    } else {
        PG8_STAGE(PG8_SB(0, 0), cB, voffB); PG8_STAGE_A(PG8_SA(0, 0), cA, 0, gcur); PG8_STAGE(PG8_SB(0, 1), cB + hstep, voffB); PG8_STAGE_A(PG8_SA(0, 1), cA, 1, gcur);
        if (wr == 1) PG8_BAR;
        PG8_WAIT_V(4); PG8_BAR;
        PG8_STAGE(PG8_SB(1, 0), cB + kstep, voffB); PG8_STAGE_A(PG8_SA(1, 0), cA + kstepA, 0, gcur); PG8_STAGE(PG8_SB(1, 1), cB + hstep + kstep, voffB);
        PG8_WAIT_V(6); PG8_BAR;
    }
    for (;;) {
        const bool has_next = S.next(ui + 1, nxt);
        const char* nA = has_next ? S.a_ptr(nxt) : cA; const char* nB = has_next ? S.b_ptr(nxt) : cB;
        if (has_next) { PG8_GOFF(gnxt, nxt); } else { _Pragma("unroll") for (int _h = 0; _h < 2; ++_h) _Pragma("unroll") for (int _i = 0; _i < 2; ++_i) gnxt[_h][_i] = gcur[_h][_i]; }
        for (int t = 0; t < nt; t += 2) {
            const bool last = (t == nt - 2);
            const char* a1 = cA + (size_t)(t + 1) * kstepA;
            const char* a2 = last ? nA : cA + (size_t)(t + 2) * kstepA; const char* b2 = last ? nB : cB + (size_t)(t + 2) * kstep;
            const char* a3 = a2 + kstepA; const char* b3 = b2 + kstep;
            unsigned gsel[2][2]; _Pragma("unroll") for (int _h = 0; _h < 2; ++_h) _Pragma("unroll") for (int _i = 0; _i < 2; ++_i) gsel[_h][_i] = last ? gnxt[_h][_i] : gcur[_h][_i];
            if (last && has_next) S.a_ready(nxt);
            if constexpr (SP2) {
            PG8_LDB(B0, 0, 0); PG8_LDB(B1, 0, 1); PG8_SCHED; PG8_LDA(At, 0, 0); PG8_STAGE_A(PG8_SA(1, 1), a1, 1, gcur);
            PG8_WAIT_V(8); PG8_WAIT_L(0); PG8_BAR; PG8_MMA(0, 0, At, B0); PG8_MMA(0, 1, At, B1); PG8_BAR; PG8_SCHED;
            PG8_LDA(At, 0, 1); PG8_STAGE(PG8_SB(0, 0), b2, voffB); PG8_STAGE(PG8_SB(0, 1), b2 + hstep, voffB); PG8_STAGE_A(PG8_SA(0, 0), a2, 0, gsel);
            PG8_WAIT_V(8); PG8_WAIT_L(0); PG8_BAR; PG8_MMA(1, 0, At, B0); PG8_MMA(1, 1, At, B1); PG8_BAR; PG8_SCHED;
            PG8_LDB(B0, 1, 0); PG8_LDB(B1, 1, 1); PG8_SCHED; PG8_LDA(At, 1, 0); PG8_STAGE_A(PG8_SA(0, 1), a2, 1, gsel);
            PG8_WAIT_V(8); PG8_WAIT_L(0); PG8_BAR; PG8_MMA(0, 0, At, B0); PG8_MMA(0, 1, At, B1); PG8_BAR; PG8_SCHED;
            PG8_LDA(At, 1, 1); PG8_STAGE(PG8_SB(1, 0), b3, voffB); PG8_STAGE(PG8_SB(1, 1), b3 + hstep, voffB); PG8_STAGE_A(PG8_SA(1, 0), a3, 0, gsel);
            PG8_WAIT_V(8); PG8_WAIT_L(0); PG8_BAR; PG8_MMA(1, 0, At, B0); PG8_MMA(1, 1, At, B1); PG8_BAR; PG8_SCHED;
            } else {
            PG8_LDB(B0, 0, 0); PG8_SCHED; PG8_LDA(At, 0, 0); PG8_STAGE_A(PG8_SA(1, 1), a1, 1, gcur);
            PG8_WAIT_L(8); PG8_BAR; PG8_WAIT_L(0); PG8_MMA(0, 0, At, B0); PG8_BAR; PG8_SCHED;
            PG8_LDB(B1, 0, 1); PG8_STAGE(PG8_SB(0, 0), b2, voffB);
            PG8_BAR; PG8_WAIT_L(0); PG8_MMA(0, 1, At, B1); PG8_BAR;
            PG8_LDA(At, 0, 1); PG8_STAGE_A(PG8_SA(0, 0), a2, 0, gsel);
            PG8_BAR; PG8_WAIT_L(0); PG8_MMA(1, 0, At, B0); PG8_BAR; PG8_SCHED;
            PG8_STAGE(PG8_SB(0, 1), b2 + hstep, voffB);
            PG8_WAIT_V(6); PG8_BAR; PG8_MMA(1, 1, At, B1); PG8_BAR;
            PG8_LDB(B0, 1, 0); PG8_SCHED; PG8_LDA(At, 1, 0); PG8_STAGE_A(PG8_SA(0, 1), a2, 1, gsel);
            PG8_WAIT_L(8); PG8_BAR; PG8_WAIT_L(0); PG8_MMA(0, 0, At, B0); PG8_BAR; PG8_SCHED;
            PG8_LDB(B1, 1, 1); PG8_STAGE(PG8_SB(1, 0), b3, voffB);
            PG8_BAR; PG8_WAIT_L(0); PG8_MMA(0, 1, At, B1); PG8_BAR;
            PG8_LDA(At, 1, 1); PG8_STAGE_A(PG8_SA(1, 0), a3, 0, gsel);
            PG8_BAR; PG8_WAIT_L(0); PG8_MMA(1, 0, At, B0); PG8_BAR; PG8_SCHED;
            PG8_STAGE(PG8_SB(1, 1), b3 + hstep, voffB);
            PG8_WAIT_V(6); PG8_BAR; PG8_MMA(1, 1, At, B1); PG8_BAR;
            }
        }
        if constexpr (Sched::FP8) asm volatile("s_nop 15\n\ts_nop 15" ::: "memory");
        if constexpr (ALIGN_EPI) { if (wr == 0) PG8_BAR; }
#if defined(PROBE_SEC)
        unsigned long long pt_e0 = 0ull; if (Epi::PID + 10 == PROBE_SEC) pt_e0 = __builtin_amdgcn_s_memrealtime();
#endif
        if constexpr (!Epi::AFTER_DRAIN) { E(acc, cur, wr, wc, fr, fq); S.done(cur); }
#if defined(PROBE_SEC)
        if (Epi::PID + 10 == PROBE_SEC) { asm volatile("s_waitcnt vmcnt(0)" ::: "memory"); pt_acc += __builtin_amdgcn_s_memrealtime() - pt_e0; }
#endif
        if (!has_next) break;
#pragma unroll
        for (int a = 0; a < 2; ++a)
#pragma unroll
            for (int b = 0; b < 2; ++b)
#pragma unroll
                for (int m = 0; m < 4; ++m)
#pragma unroll
                    for (int n = 0; n < 2; ++n) { acc[a][b][m][n] = (f32x4){0.f, 0.f, 0.f, 0.f}; if constexpr (Sched::FP8) asm volatile("" : "+v"(acc[a][b][m][n])); }
        cur = nxt; cA = nA; cB = nB; ++ui; _Pragma("unroll") for (int _h = 0; _h < 2; ++_h) _Pragma("unroll") for (int _i = 0; _i < 2; ++_i) gcur[_h][_i] = gnxt[_h][_i];
        if constexpr (ALIGN_EPI) { if (wr == 1) PG8_BAR; }
    }
    PG8_WAIT_V(0);
    if constexpr (!ALIGN_EPI) { if (wr == 0) PG8_BAR; }
    PG8_BAR;
    if constexpr (Epi::AFTER_DRAIN) { E.fused(acc, cur, wr, wc, fr, fq, lds, wid, lane); S.done(cur); }
#undef PG8_SA
#undef PG8_SB
#undef PG8_STAGE
#undef PG8_STAGE_A
#undef PG8_GOFF
#undef PG8_LDA
#undef PG8_LDB
#undef PG8_MMA
#undef PG8_WAIT_V
#undef PG8_WAIT_L
#undef PG8_BAR
#undef PG8_SCHED
}
}

#define GAS __attribute__((address_space(1)))
#define LAS __attribute__((address_space(3)))
typedef unsigned short bf16;
typedef unsigned v4u __attribute__((ext_vector_type(4)));
typedef float f32x4 __attribute__((ext_vector_type(4)));
typedef short bf16x8 __attribute__((ext_vector_type(8)));
typedef GAS unsigned gu32;
typedef GAS unsigned long long gu64;
#define RLX_AGENT __ATOMIC_RELAXED, __HIP_MEMORY_SCOPE_AGENT
#define LDS_WAIT() asm volatile("s_waitcnt lgkmcnt(0)" ::: "memory")
#define VM_WAIT() asm volatile("s_waitcnt vmcnt(0)" ::: "memory")
__device__ __forceinline__ unsigned long long rt() { return __builtin_amdgcn_s_memrealtime(); }
__device__ __forceinline__ unsigned f2bf(float f) { unsigned u = __builtin_bit_cast(unsigned, f); return (u + 0x7fffu + ((u >> 16) & 1u)) >> 16; }
__device__ __forceinline__ unsigned pk2(float lo, float hi) { return f2bf(lo) | (f2bf(hi) << 16); }

#define XB_TMO      128
#define XB_XCNT(j)  (256  + 64 * (j))
#define XB_XSUB(j)  (1280 + 64 * (j))
#define XB_XGEN(j)  (2304 + 64 * (j))
#define XB_TOP      3328
#define XB_TOPGEN   3392
#define XCD_BAR_WORDS 3456
#define XB_SPIN_CAP (1u << 18)

__device__ __forceinline__ unsigned xb_ld(unsigned* p)              { return __hip_atomic_load(p, __ATOMIC_RELAXED, __HIP_MEMORY_SCOPE_AGENT); }
__device__ __forceinline__ unsigned xb_add(unsigned* p, unsigned v) { return __hip_atomic_fetch_add(p, v, __ATOMIC_RELAXED, __HIP_MEMORY_SCOPE_AGENT); }
__device__ __forceinline__ unsigned xb_xcc_id() { return (unsigned)__builtin_amdgcn_s_getreg((3 << 11) | 20) & 0xFu; }
#define XB_SPIN(cond, bar) do { unsigned _sp = 0; while (cond) { __builtin_amdgcn_s_sleep(1); \
    if ((++_sp & 255u) == 0u) { if (xb_ld(&(bar)[XB_TMO])) break; if (_sp > XB_SPIN_CAP) { atomicAdd(&(bar)[XB_TMO], 1u); break; } } } } while (0)

struct XcdBarrier {
    unsigned* bar; unsigned x;
    volatile LAS unsigned* st;
};

__device__ __forceinline__ XcdBarrier xcd_barrier_post(unsigned* bar, volatile LAS unsigned* st) {
    XcdBarrier b; b.bar = bar; b.x = xb_xcc_id(); b.st = st;
    if (threadIdx.x == 0) (void)xb_add(&bar[XB_XCNT(b.x)], 1u);
    return b;
}
__device__ __forceinline__ void xcd_barrier_complete(unsigned* bar, unsigned x, unsigned& nloc, unsigned& nx) {
    const unsigned G = gridDim.x * gridDim.y * gridDim.z;
    unsigned sum, cnt, mine, sp = 0u;
    for (;;) {
        sum = 0u; cnt = 0u; mine = 0u;
#pragma unroll
        for (unsigned j = 0; j < 16; ++j) { const unsigned c = xb_ld(&bar[XB_XCNT(j)]); sum += c; cnt += (c > 0u) ? 1u : 0u; mine = (j == x) ? c : mine; }
        if (sum == G) break;
        __builtin_amdgcn_s_sleep(1);
        if ((++sp & 255u) == 0u) { if (xb_ld(&bar[XB_TMO])) break; if (sp > XB_SPIN_CAP) { atomicAdd(&bar[XB_TMO], 1u); break; } }
    }
    nloc = mine > 0u ? mine : 1u; nx = cnt > 0u ? cnt : 1u;
}

__device__ __forceinline__ void xcd_barrier(const XcdBarrier& b, const int xb_tid  ) {
    asm volatile("s_waitcnt vmcnt(0)" ::: "memory");
    __syncthreads();
    if (xb_tid == 0) {
        unsigned* bar = b.bar;
        __builtin_amdgcn_s_waitcnt(0);
        unsigned nloc = b.st[0], nx = b.st[1];
        if (nloc == 0u) { xcd_barrier_complete(bar, b.x, nloc, nx); b.st[0] = nloc; b.st[1] = nx; }
        const unsigned old = xb_add(&bar[XB_XSUB(b.x)], 1u);
        const unsigned gen = old / nloc;
        if (old + 1u == (gen + 1u) * nloc) {
            __builtin_amdgcn_fence(__ATOMIC_RELEASE, "agent");
            asm volatile("s_waitcnt vmcnt(0)" ::: "memory");
            const unsigned og = xb_add(&bar[XB_TOP], 1u);
            const unsigned tg = og / nx;
            if (og + 1u == (tg + 1u) * nx) xb_add(&bar[XB_TOPGEN], 1u);
            else XB_SPIN(xb_ld(&bar[XB_TOPGEN]) == tg, bar);
            __builtin_amdgcn_fence(__ATOMIC_ACQUIRE, "agent");
            xb_add(&bar[XB_XGEN(b.x)], 1u);
            asm volatile("s_waitcnt vmcnt(0)" ::: "memory");
        } else {
            XB_SPIN(xb_ld(&bar[XB_XGEN(b.x)]) == gen, bar);
            __builtin_amdgcn_fence(__ATOMIC_ACQUIRE, "agent");
            asm volatile("s_waitcnt vmcnt(0)" ::: "memory");
        }
    }
    __syncthreads();
}

constexpr int NWAVES = 8;
constexpr int D = 1024, BATCH = 16, SEQ = 4096, DEPTH = 4, M = BATCH * SEQ;
constexpr int CHUNK = 64, NCHUNK = SEQ / CHUNK, MEM_LEN = 256, MROWS = BATCH * MEM_LEN;
constexpr int HG_H = 4, HG_D = 128, HG_W = 512, AT_H = 8, AT_D = 64, AT_W = 512, LEFTC = 8, MAXREL = 128, NREL = 257;
constexpr int INW = 3584;
constexpr int C_HQ = 0, C_HF = 512, C_HI = 1024, C_HGT = 1536, C_AQ = 2048, C_AK = 2560, C_AV = 3072;
constexpr int MH = 4, MHD = 256, FF = 2816, NE = 8, FFE = 3584;
constexpr int ROWS_PAD = M + NE * 256;
constexpr int MAXPANEL = ROWS_PAD / 256;
constexpr float EPS = 1e-6f;
enum { I_X = 0, I_MEM, I_WIN, I_LB, I_HGAIN, I_RELB, I_AGAIN, I_WOUT, I_NMIX, I_NMQ, I_NMKV, I_WMQ, I_WMKV, I_WMO, I_NFFN, I_WG, I_WU, I_WD, I_WR, I_EG, I_EU, I_ED, I_NFIN, N_IN };

constexpr size_t MiB = 1u << 20;
constexpr size_t WS_CTL = 0, CTL_ZERO_BYTES = 1 * MiB;
constexpr size_t WS_SS = 1 * MiB;
constexpr size_t WS_SSM = 5 * MiB;
constexpr size_t WS_RT = 8 * MiB;
constexpr size_t RT_TOKE = 0, RT_TOKG = 256 * 1024, RT_TOKRS = 768 * 1024, RT_ROWTOK = 1 * MiB, RT_ROWGATE = 1 * MiB + 768 * 1024, RT_ROWRS = 2 * MiB + 512 * 1024, RT_LB = 3 * MiB + 256 * 1024, RT_TOKROW0 = 3 * MiB + 512 * 1024;
constexpr size_t WS_MB = 12 * MiB;
constexpr size_t WS_KV = 20 * MiB;
constexpr size_t WS_W = 84 * MiB;
constexpr size_t W_LAYER = 13 * MiB, W_IN = 0, W_OUT = 7 * MiB, W_MQ = 9 * MiB, W_MO = 11 * MiB;
constexpr size_t W_KV = 52 * MiB;
constexpr size_t W_FFN = 68 * MiB, W_FFN_STRIDE = 17 * MiB, W_FFN_GU = 0, W_FFN_D = 11 * MiB;
constexpr size_t WS_WM = 188 * MiB, WM_ESTRIDE = 21 * MiB, WM_GU = 0, WM_D = 14 * MiB;
constexpr size_t WS_HB = 356 * MiB;
constexpr size_t WS_MIX = 484 * MiB;
constexpr size_t WS_BIG = 616 * MiB;
constexpr size_t WS_GV = 1078 * MiB;
constexpr size_t WS_END = 1084 * MiB;
static_assert(WS_W + W_FFN + 2 * W_FFN_STRIDE <= WS_WM && WS_WM + 8 * WM_ESTRIDE <= WS_HB && WS_MIX + (size_t)ROWS_PAD * D * 2 <= WS_BIG && WS_BIG + (size_t)ROWS_PAD * FFE * 2 <= WS_GV && WS_GV + (size_t)(M / 64) * 1536 * 4 <= WS_END, "ws map");
static_assert((size_t)5632 * 1024 * 2 <= W_FFN_D && W_FFN_D + (size_t)1024 * 2816 * 2 <= W_FFN_STRIDE && (size_t)7168 * 1024 * 2 <= WM_D && WM_D + (size_t)1024 * 3584 * 2 <= WM_ESTRIDE, "weight map");
constexpr int CW_TMO = 0, CW_CODE = 1, CW_BAR = 4096, CW_MOE = 16384, CW_SUB = 20480;
constexpr int RING_BYTES = 131072, LDSCTL_OFF = 149504, MISC_OFF = LDSCTL_OFF + 320, PEXP_OFF = LDSCTL_OFF + 1024, LDS_BYTES = 153600;
static_assert(PEXP_OFF + MAXPANEL * 4 + 64 <= LDS_BYTES, "LDS map");

typedef unsigned u32x2 __attribute__((ext_vector_type(2)));
__device__ __forceinline__ float bf2f(unsigned short b) { return __uint_as_float(((unsigned)b) << 16); }
__device__ __forceinline__ float bflo(unsigned w) { return __uint_as_float(w << 16); }
__device__ __forceinline__ float bfhi(unsigned w) { return __uint_as_float(w & 0xffff0000u); }
__device__ __forceinline__ unsigned cvtpk(float lo, float hi) { return pg8::cvt_pk_bf16(lo, hi); }
__device__ __forceinline__ float wave_sum(float v) { return pg8::sum_x32(pg8::sum_x16(pg8::row_sum16(v))); }
__device__ __forceinline__ float wave_max(float v) { return pg8::max_x32(pg8::max_x16(pg8::row_max16(v))); }
struct Args { const float* in[N_IN]; float* out; unsigned char* ws; int ph_lo, ph_hi, flags, pad; };

__device__ __forceinline__ void cvt_item(const float* W, int ldw, int K, const float* gain, bf16* WTrow, int k0, int n0, LAS unsigned* scr, int lane) {
    const int nq = (lane & 15) * 4, kq = lane >> 4;
    f32x4 va[8], vb[8];
#pragma unroll
    for (int i = 0; i < 8; ++i) { const int k = k0 + 8 * i + 2 * kq; va[i] = *(const GAS f32x4*)(W + (size_t)k * ldw + n0 + nq); vb[i] = *(const GAS f32x4*)(W + (size_t)(k + 1) * ldw + n0 + nq); }
#pragma unroll
    for (int i = 0; i < 8; ++i) { const int kl = 8 * i + 2 * kq; float g0 = 1.0f, g1 = 1.0f; if (gain) { g0 = gain[k0 + kl]; g1 = gain[k0 + kl + 1]; }
#pragma unroll
        for (int j = 0; j < 4; ++j) scr[(nq + j) * 33 + (kl >> 1)] = cvtpk(va[i][j] * g0, vb[i][j] * g1); }
    LDS_WAIT(); asm volatile("" ::: "memory");
#pragma unroll
    for (int i = 0; i < 8; ++i) { const int n = 8 * i + (lane >> 3), c = lane & 7; const LAS unsigned* s = scr + n * 33 + 4 * c;
        v4u o; o.x = s[0]; o.y = s[1]; o.z = s[2]; o.w = s[3];
        *(GAS v4u*)(WTrow + (size_t)n * K + k0 + 8 * c) = o; }
    LDS_WAIT(); asm volatile("" ::: "memory");
}
__device__ __forceinline__ void cvt_matrix(const float* W0, const float* W1, int K, int ldw, int NOUT, bf16* WT, const float* gain, LAS unsigned* scr, int lane, int& rot, int gw, int ngw) {
    const int nblk = NOUT / 64, items = (K / 64) * nblk;
    int w0 = gw - rot; if (w0 < 0) w0 += ngw;
    for (int it = w0; it < items; it += ngw) {
        const int kb = it / nblk, nb = it - kb * nblk, R0 = nb * 64; const float* W = W0; int n0 = R0;
        if (W1) { const int tile = R0 >> 8, rr = R0 & 255; W = (rr < 128) ? W0 : W1; n0 = tile * 128 + (rr & 127); }
        cvt_item(W, ldw, K, gain, WT + (size_t)R0 * K, kb * 64, n0, scr, lane);
    }
    rot = (rot + items) % ngw;
}
__device__ __forceinline__ void cvt_item8(const float* W, int ldw, int K, const float* gain, float sc, unsigned char* WTrow, int k0, int n0, LAS unsigned* scr, int lane) {
    const int nq = (lane & 15) * 4, kq = lane >> 4;
    f32x4 v[4][4];
#pragma unroll
    for (int i = 0; i < 4; ++i)
#pragma unroll
        for (int r = 0; r < 4; ++r) v[i][r] = *(const GAS f32x4*)(W + (size_t)(k0 + 16 * i + 4 * kq + r) * ldw + n0 + nq);
#pragma unroll
    for (int i = 0; i < 4; ++i) { const int kl = 16 * i + 4 * kq; float g[4] = {sc, sc, sc, sc};
        if (gain) { const f32x4 gv = *(const f32x4*)(gain + k0 + kl); g[0] = gv.x * sc; g[1] = gv.y * sc; g[2] = gv.z * sc; g[3] = gv.w * sc; }
#pragma unroll
        for (int j = 0; j < 4; ++j) scr[(nq + j) * 17 + (kl >> 2)] = pg8::pk_fp8x4(v[i][0][j] * g[0], v[i][1][j] * g[1], v[i][2][j] * g[2], v[i][3][j] * g[3]); }
    LDS_WAIT(); asm volatile("" ::: "memory");
#pragma unroll
    for (int i = 0; i < 4; ++i) { const int n = 16 * i + (lane >> 2), c = lane & 3; const LAS unsigned* s = scr + n * 17 + 4 * c;
        v4u o; o.x = s[0]; o.y = s[1]; o.z = s[2]; o.w = s[3];
        *(GAS v4u*)(WTrow + (size_t)n * K + k0 + 16 * c) = o; }
    LDS_WAIT(); asm volatile("" ::: "memory");
}
__device__ __forceinline__ void cvt_matrix8(const float* W0, const float* W1, int K, int ldw, int NOUT, unsigned char* WT, const float* gain, float sc, LAS unsigned* scr, int lane, int& rot, int gw, int ngw) {
    const int nblk = NOUT / 64, items = (K / 64) * nblk;
    int w0 = gw - rot; if (w0 < 0) w0 += ngw;
    for (int it = w0; it < items; it += ngw) {
        const int kb = it / nblk, nb = it - kb * nblk, R0 = nb * 64; const float* W = W0; int n0 = R0;
        if (W1) { const int tile = R0 >> 8, rr = R0 & 255; W = (rr < 128) ? W0 : W1; n0 = tile * 128 + (rr & 127); }
        cvt_item8(W, ldw, K, gain, sc, WT + (size_t)R0 * K, kb * 64, n0, scr, lane);
    }
    rot = (rot + items) % ngw;
}
__device__ __forceinline__ float row_to_bf16(const float* xrow, bf16* orow, int lane) {
    const GAS f32x4* xr = (const GAS f32x4*)xrow + lane; f32x4 v[4]; float s = 0.f;
#pragma unroll
    for (int j = 0; j < 4; ++j) { v[j] = xr[64 * j]; s += (v[j].x * v[j].x + v[j].y * v[j].y) + (v[j].z * v[j].z + v[j].w * v[j].w); }
    GAS u32x2* o8 = (GAS u32x2*)orow + lane;
#pragma unroll
    for (int j = 0; j < 4; ++j) { u32x2 w; w.x = cvtpk(v[j].x, v[j].y); w.y = cvtpk(v[j].z, v[j].w); o8[64 * j] = w; }
    return wave_sum(s);
}

__device__ __forceinline__ float row_to_stream(const float* xrow, unsigned char* srow, int lane) {
    float s = 0.f;
#pragma unroll
    for (int gq = 0; gq < 2; ++gq) { const int g = 64 * gq + lane; const f32x4 a = *(const GAS f32x4*)(xrow + 8 * g), c = *(const GAS f32x4*)(xrow + 8 * g + 4);
        const float h[8] = {a.x, a.y, a.z, a.w, c.x, c.y, c.z, c.w};
#pragma unroll
        for (int j = 0; j < 8; ++j) s += h[j] * h[j];
        pg8::hl_store8(srow + g * 16, h); }
    return wave_sum(s);
}
__device__ __forceinline__ void naive_chunk_attn(const bf16* PROJ, bf16* MIX, const float* relb  , int w0, int nw, int lane) {
    for (int u = w0; u < BATCH * NCHUNK * AT_H; u += nw) {
        const int h = u & 7, c = (u >> 3) & 63, b = u >> 9;
        const size_t rowq = (size_t)b * SEQ + c * CHUNK + lane;
        float q[64], o[64];
        { const v4u* qp = (const v4u*)(PROJ + rowq * INW + C_AQ + h * AT_D);
#pragma unroll
          for (int d8 = 0; d8 < 8; ++d8) { const v4u w = qp[d8]; q[d8 * 8 + 0] = bflo(w.x) * 0.125f; q[d8 * 8 + 1] = bfhi(w.x) * 0.125f; q[d8 * 8 + 2] = bflo(w.y) * 0.125f; q[d8 * 8 + 3] = bfhi(w.y) * 0.125f;
              q[d8 * 8 + 4] = bflo(w.z) * 0.125f; q[d8 * 8 + 5] = bfhi(w.z) * 0.125f; q[d8 * 8 + 6] = bflo(w.w) * 0.125f; q[d8 * 8 + 7] = bfhi(w.w) * 0.125f; } }
#pragma unroll
        for (int d = 0; d < 64; ++d) o[d] = 0.f;
        float mx = -1e30f, l = 0.f;
        const int klo = (c > LEFTC ? c - LEFTC : 0) * CHUNK, khi = c * CHUNK + CHUNK, qpos = c * CHUNK + lane;
        const float* bh = relb + h * NREL;
        for (int kp = klo; kp < khi; ++kp) {
            const bf16* kr = PROJ + ((size_t)b * SEQ + kp) * INW + C_AK + h * AT_D;
            float s = 0.f;
#pragma unroll
            for (int d8 = 0; d8 < 8; ++d8) { const v4u w = ((const v4u*)kr)[d8];
                s += q[d8 * 8 + 0] * bflo(w.x) + q[d8 * 8 + 1] * bfhi(w.x) + q[d8 * 8 + 2] * bflo(w.y) + q[d8 * 8 + 3] * bfhi(w.y) + q[d8 * 8 + 4] * bflo(w.z) + q[d8 * 8 + 5] * bfhi(w.z) + q[d8 * 8 + 6] * bflo(w.w) + q[d8 * 8 + 7] * bfhi(w.w); }
            int rel = qpos - kp; rel = rel < -MAXREL ? -MAXREL : (rel > MAXREL ? MAXREL : rel);
            s += bh[rel + MAXREL];
            const float mn = fmaxf(mx, s), al = __expf(mx - mn), p = __expf(s - mn);
            l = l * al + p; mx = mn;
            const bf16* vr = kr + (C_AV - C_AK);
#pragma unroll
            for (int d8 = 0; d8 < 8; ++d8) { const v4u w = ((const v4u*)vr)[d8];
                o[d8 * 8 + 0] = o[d8 * 8 + 0] * al + p * bflo(w.x); o[d8 * 8 + 1] = o[d8 * 8 + 1] * al + p * bfhi(w.x); o[d8 * 8 + 2] = o[d8 * 8 + 2] * al + p * bflo(w.y); o[d8 * 8 + 3] = o[d8 * 8 + 3] * al + p * bfhi(w.y);
                o[d8 * 8 + 4] = o[d8 * 8 + 4] * al + p * bflo(w.z); o[d8 * 8 + 5] = o[d8 * 8 + 5] * al + p * bfhi(w.z); o[d8 * 8 + 6] = o[d8 * 8 + 6] * al + p * bflo(w.w); o[d8 * 8 + 7] = o[d8 * 8 + 7] * al + p * bfhi(w.w); }
        }
        const float il = 1.0f / l;
        v4u* op = (v4u*)(MIX + rowq * D + HG_W + h * AT_D);
#pragma unroll
        for (int d8 = 0; d8 < 8; ++d8) { v4u w; w.x = cvtpk(o[d8 * 8 + 0] * il, o[d8 * 8 + 1] * il); w.y = cvtpk(o[d8 * 8 + 2] * il, o[d8 * 8 + 3] * il); w.z = cvtpk(o[d8 * 8 + 4] * il, o[d8 * 8 + 5] * il); w.w = cvtpk(o[d8 * 8 + 6] * il, o[d8 * 8 + 7] * il); op[d8] = w; }
    }
}
__device__ __forceinline__ void naive_hgrn(const bf16* PROJ, bf16* MIX, const float* lb  , int bh, LAS float* L, int tid) {
    const int b = bh >> 2, h = bh & 3;
    LAS float* Lf = L; LAS float* Lk = L + 8192; LAS float* Lq = L + 16384; LAS float* Lv = L + 24576;
    float S[128];
#pragma unroll
    for (int d = 0; d < 128; ++d) S[d] = 0.f;
    for (int c = 0; c < NCHUNK; ++c) {
        __syncthreads();
#pragma unroll 4
        for (int i = 0; i < 16; ++i) { const int idx = tid + 512 * i, t = idx >> 7, d = idx & 127;
            const bf16* pr = PROJ + ((size_t)b * SEQ + c * CHUNK + t) * INW + h * HG_D + d;
            const float qv = bf2f(pr[C_HQ]), fl = bf2f(pr[C_HF]), iv = bf2f(pr[C_HI]); const float lbv = lb[h * HG_D + d];
            const float f = lbv + (1.0f - lbv) / (1.0f + __expf(-fl));
            Lf[idx] = f; Lk[idx] = 1.0f - f; Lq[idx] = qv; Lv[idx] = iv; }
        __syncthreads();
        if (tid < 128) {
            for (int t = 0; t < CHUNK; ++t) {
                const float v = Lv[t * 128 + tid]; float o = 0.f;
#pragma unroll
                for (int d = 0; d < 128; d += 4) { const f32x4 f4 = *(const LAS f32x4*)(Lf + t * 128 + d), k4 = *(const LAS f32x4*)(Lk + t * 128 + d), q4 = *(const LAS f32x4*)(Lq + t * 128 + d);
                    S[d + 0] = S[d + 0] * f4.x + k4.x * v; o += q4.x * S[d + 0]; S[d + 1] = S[d + 1] * f4.y + k4.y * v; o += q4.y * S[d + 1];
                    S[d + 2] = S[d + 2] * f4.z + k4.z * v; o += q4.z * S[d + 2]; S[d + 3] = S[d + 3] * f4.w + k4.w * v; o += q4.w * S[d + 3]; }
                MIX[((size_t)b * SEQ + c * CHUNK + t) * D + h * HG_D + tid] = (bf16)f2bf(o);
            }
        }
    }
    __syncthreads();
}
__device__ __forceinline__ void post_rows(bf16* MIX, const float* again, int w0, int nw, int lane) {
    float ga[8];
#pragma unroll
    for (int j = 0; j < 8; ++j) ga[j] = again[lane * 8 + j];
    for (int r0 = w0; r0 < M; r0 += 4 * nw) {
        v4u w[4];
#pragma unroll
        for (int q = 0; q < 4; ++q) { const int r = r0 + q * nw; w[q] = (r < M) ? ((const v4u*)(MIX + (size_t)r * D))[64 + lane] : (v4u){0u, 0u, 0u, 0u}; }
#pragma unroll
        for (int q = 0; q < 4; ++q) { const int r = r0 + q * nw; if (r < M) {
            const float x[8] = {bflo(w[q].x), bfhi(w[q].x), bflo(w[q].y), bfhi(w[q].y), bflo(w[q].z), bfhi(w[q].z), bflo(w[q].w), bfhi(w[q].w)};
            float ss = 0.f;
#pragma unroll
            for (int j = 0; j < 8; ++j) ss += x[j] * x[j];
            ss = wave_sum(ss); const float rs = 1.0f / sqrtf(ss * (1.0f / 512.0f) + EPS);
            v4u o; o.x = cvtpk(x[0] * rs * ga[0], x[1] * rs * ga[1]); o.y = cvtpk(x[2] * rs * ga[2], x[3] * rs * ga[3]); o.z = cvtpk(x[4] * rs * ga[4], x[5] * rs * ga[5]); o.w = cvtpk(x[6] * rs * ga[6], x[7] * rs * ga[7]);
            ((v4u*)(MIX + (size_t)r * D))[64 + lane] = o; } }
    }
}
__device__ __forceinline__ void naive_mem_attn(const bf16* Q, const bf16* KV, bf16* O, int layer, int w0, int nw, int lane) {
    for (int u = w0; u < BATCH * MH * SEQ; u += nw) {
        const int qi = u & (SEQ - 1), h = (u >> 12) & 3, b = u >> 14;
        const size_t row = (size_t)b * SEQ + qi;
        const bf16* Qp = Q + row * D + h * MHD;
        const bf16* Kb = KV + (size_t)b * MEM_LEN * (DEPTH * 2048) + layer * 2048 + h * MHD; const bf16* Vb = Kb + 1024;
        float s[4] = {0.f, 0.f, 0.f, 0.f};
#pragma unroll 4
        for (int d8 = 0; d8 < 32; ++d8) { const v4u qw = ((const v4u*)Qp)[d8]; const float qf[8] = {bflo(qw.x), bfhi(qw.x), bflo(qw.y), bfhi(qw.y), bflo(qw.z), bfhi(qw.z), bflo(qw.w), bfhi(qw.w)};
#pragma unroll
            for (int i = 0; i < 4; ++i) { const v4u kw = *(const v4u*)(Kb + (size_t)(lane + 64 * i) * (DEPTH * 2048) + d8 * 8);
                s[i] += qf[0] * bflo(kw.x) + qf[1] * bfhi(kw.x) + qf[2] * bflo(kw.y) + qf[3] * bfhi(kw.y) + qf[4] * bflo(kw.z) + qf[5] * bfhi(kw.z) + qf[6] * bflo(kw.w) + qf[7] * bfhi(kw.w); } }
        float mx = -1e30f;
#pragma unroll
        for (int i = 0; i < 4; ++i) { s[i] *= 0.0625f; mx = fmaxf(mx, s[i]); }
        mx = wave_max(mx); float p[4], sum = 0.f;
#pragma unroll
        for (int i = 0; i < 4; ++i) { p[i] = __expf(s[i] - mx); sum += p[i]; }
        sum = wave_sum(sum);
        float o0 = 0.f, o1 = 0.f, o2 = 0.f, o3 = 0.f;
#pragma unroll
        for (int i = 0; i < 4; ++i) {
#pragma unroll 8
            for (int kk = 0; kk < 64; ++kk) { const float pk = __shfl(p[i], kk); const u32x2 vw = *(const u32x2*)(Vb + (size_t)(kk + 64 * i) * (DEPTH * 2048) + lane * 4);
                o0 += pk * bflo(vw.x); o1 += pk * bfhi(vw.x); o2 += pk * bflo(vw.y); o3 += pk * bfhi(vw.y); } }
        const float il = 1.0f / sum; u32x2 w; w.x = cvtpk(o0 * il, o1 * il); w.y = cvtpk(o2 * il, o3 * il);
        *(u32x2*)(O + row * D + h * MHD + lane * 4) = w;
    }
}

#if defined(PROBE_SEC)
#define PT_BEGIN(n) unsigned long long pt_t0_##n = 0ull; if ((n) == PROBE_SEC) pt_t0_##n = __builtin_amdgcn_s_memrealtime();
#define PT_END(n) if ((n) == PROBE_SEC) pt_acc += __builtin_amdgcn_s_memrealtime() - pt_t0_##n;
#define PT_PARAM , unsigned long long& pt_acc
#else
#define PT_BEGIN(n)
#define PT_END(n)
#define PT_PARAM
#endif

typedef float f32x16 __attribute__((ext_vector_type(16)));
typedef short s16x4 __attribute__((ext_vector_type(4)));
typedef short v4i16_t __attribute__((ext_vector_type(4)));
typedef float f32x2t __attribute__((ext_vector_type(2)));
typedef __bf16 bf16x2t __attribute__((ext_vector_type(2)));
__device__ __forceinline__ unsigned cvtpk_c(float lo, float hi) { f32x2t v = {lo, hi}; bf16x2t b = __builtin_convertvector(v, bf16x2t); return __builtin_bit_cast(unsigned, b); }
__device__ __forceinline__ s16x4 vtr(const LAS unsigned char* p) { return __builtin_bit_cast(s16x4, __builtin_amdgcn_ds_read_tr16_b64_v4i16((LAS v4i16_t*)p)); }
#define MFMA32(a, b, c) __builtin_amdgcn_mfma_f32_32x32x16_bf16((a), (b), (c), 0, 0, 0)
__device__ __forceinline__ int crow16(int i, int hh) { return (i & 3) + 8 * (i >> 2) + 4 * hh; }
__device__ __forceinline__ bf16x8 pack8(const f32x16& x, int s) {
    v4u w; w.x = cvtpk_c(x[8 * s + 0], x[8 * s + 1]); w.y = cvtpk_c(x[8 * s + 2], x[8 * s + 3]); w.z = cvtpk_c(x[8 * s + 4], x[8 * s + 5]); w.w = cvtpk_c(x[8 * s + 6], x[8 * s + 7]);
    return __builtin_bit_cast(bf16x8, w);
}

__device__ __forceinline__ void vt_pass(const bf16* KVb, unsigned char* VT, int bx, int G, int tid) {
    constexpr int KVLD = DEPTH * 2048, VTLD = BATCH * MEM_LEN;
    for (int t = bx; t < BATCH * DEPTH * MH; t += G) { const int b = t & 15, lh = t >> 4;
        const bf16* src = KVb + (size_t)(b * MEM_LEN) * KVLD + (lh >> 2) * 2048 + 1024 + (lh & 3) * MHD;
        unsigned char* dst = VT + (size_t)(lh * MHD) * VTLD + b * MEM_LEN;
        for (int it = tid; it < MHD * 16; it += NWAVES * 64) { const int d = it & 255, ch = it >> 8, i = ch >> 1, hq = ch & 1; float v[16];
#pragma unroll
            for (int j = 0; j < 16; ++j) { const int kv = 32 * i + (j & 3) + 8 * (j >> 2) + 4 * hq; v[j] = bf2f(src[(size_t)kv * KVLD + d]) * pg8::F8_V; }
            v4u o; o.x = pg8::pk_fp8x4(v[0], v[1], v[2], v[3]); o.y = pg8::pk_fp8x4(v[4], v[5], v[6], v[7]); o.z = pg8::pk_fp8x4(v[8], v[9], v[10], v[11]); o.w = pg8::pk_fp8x4(v[12], v[13], v[14], v[15]);
            *(v4u*)(dst + (size_t)d * VTLD + ch * 16) = o; } }
}
typedef int i32x8m __attribute__((ext_vector_type(8)));
typedef unsigned u32x8m __attribute__((ext_vector_type(8)));
__device__ __forceinline__ f32x16 mfma8_32x32x64(v4u a0, v4u a1, v4u b0, v4u b1, f32x16 c) {
    const u32x8m A = __builtin_shufflevector(a0, a1, 0, 1, 2, 3, 4, 5, 6, 7), B = __builtin_shufflevector(b0, b1, 0, 1, 2, 3, 4, 5, 6, 7);
    const i32x8m Ai = __builtin_bit_cast(i32x8m, A), Bi = __builtin_bit_cast(i32x8m, B);
    asm volatile("v_mfma_f32_32x32x64_f8f6f4 %0, %1, %2, %0" : "+v"(c) : "v"(Ai), "v"(Bi));
    return c;
}
__device__ __forceinline__ void mem_attn_phase(const unsigned char* Q8, const bf16* KVb, const unsigned char* VT, unsigned char* O8, int layer, LAS unsigned char* L, int tid, int bx, int G PT_PARAM) {
    const int lane = tid & 63, wid = __builtin_amdgcn_readfirstlane(tid >> 6), r = lane & 31, hh = lane >> 5;
    constexpr int KVLD = DEPTH * 2048, VTLD = BATCH * MEM_LEN;
    const int fx = ((r & 3) << 2) | ((r >> 2) & 3);
    const float csc = 0.0625f * 1.4426950408889634f / (pg8::F8_Q * pg8::F8_K);
    for (int u = bx; u < BATCH * MH * 16; u += G) {
        const int qb = u & 15, h = (u >> 4) & 3, b = u >> 6;
        const unsigned char* VT8b = VT + (size_t)((layer * MH + h) * MHD) * VTLD + b * MEM_LEN;
        const unsigned char* K8b = (const unsigned char*)KVb + (size_t)(b * MEM_LEN) * (KVLD * 2) + layer * 4096 + h * MHD;
        const size_t rowq0 = (size_t)b * SEQ + qb * 256 + wid * 32;
        v4u qf[8];
        const unsigned char* qp = Q8 + (rowq0 + r) * D + h * MHD + hh * 16;
#pragma unroll
        for (int i = 0; i < 8; ++i) qf[i] = *(const v4u*)(qp + i * 32);
        f32x16 sacc[8];
#pragma unroll
        for (int i = 0; i < 8; ++i)
#pragma unroll
            for (int j = 0; j < 16; ++j) sacc[i][j] = 0.f;
        v4u pf[8]; f32x16 oacc[8]; float inv = 0.f;
#define MA_DMA_K(s, bufo) do { const int kvh_ = (s); int ln_ = lane; asm volatile("" : "+v"(ln_));   \
        _Pragma("unroll") for (int i_ = 0; i_ < 4; ++i_) { const int row_ = 16 * wid + 4 * i_ + (ln_ >> 4); \
            const int ch_ = (ln_ & 15) ^ (((row_ & 3) << 2) | ((row_ >> 2) & 3)); \
            __builtin_amdgcn_global_load_lds((const unsigned*)(K8b + (size_t)(128 * kvh_ + row_) * (KVLD * 2) + ch_ * 16), (LAS unsigned*)(L + (bufo) + (16 * wid + 4 * i_) * 256), 16, 0, 0); } } while (0)
#define MA_DMA_V(vs, bufo) do { int ln_ = lane; asm volatile("" : "+v"(ln_)); \
        _Pragma("unroll") for (int i_ = 0; i_ < 4; ++i_) { const int row_ = 16 * wid + 4 * i_ + (ln_ >> 4); \
            const int ch_ = (ln_ & 15) ^ (((row_ & 3) << 2) | ((row_ >> 2) & 3)); \
            __builtin_amdgcn_global_load_lds((const unsigned*)(VT8b + (size_t)(128 * (vs) + row_) * VTLD + ch_ * 16), (LAS unsigned*)(L + (bufo) + (16 * wid + 4 * i_) * 256), 16, 0, 0); } } while (0)
        MA_DMA_K(0, 0); MA_DMA_K(1, 32768);
#pragma unroll
        for (int s = 0; s < 4; ++s) {
            const int bufo = (s % 3) * 32768, nbufo = ((s + 2) % 3) * 32768;
            PT_BEGIN(31)
            if (s < 3) asm volatile("s_waitcnt vmcnt(4)" ::: "memory"); else asm volatile("s_waitcnt vmcnt(0)" ::: "memory");
            __syncthreads();
            if (s + 2 < 4) MA_DMA_V(s, nbufo);
            PT_END(31)
            PT_BEGIN(32)
            if (s < 2) {
                const int kvh = s;
#pragma unroll
                for (int blk = 0; blk < 4; ++blk) { const LAS unsigned char* rp = L + bufo + (32 * blk + r) * 256; v4u kf[8];
#pragma unroll
                    for (int i = 0; i < 8; ++i) kf[i] = *(const LAS v4u*)(rp + (((2 * i + hh) ^ fx) << 4));
                    __builtin_amdgcn_sched_barrier(0);
#pragma unroll
                    for (int j = 0; j < 4; ++j) sacc[4 * kvh + blk] = mfma8_32x32x64(kf[2 * j], kf[2 * j + 1], qf[2 * j], qf[2 * j + 1], sacc[4 * kvh + blk]);
                    __builtin_amdgcn_sched_barrier(0); }
                if (s == 1) { asm volatile("s_nop 15\n\ts_nop 15\n\ts_nop 7" ::: "memory");
                    float sum = 0.f;
#pragma unroll
                    for (int i = 0; i < 8; ++i) {
#pragma unroll
                        for (int j = 0; j < 16; ++j) { const float p = __builtin_amdgcn_exp2f(sacc[i][j] * csc - 8.0f); sacc[i][j] = p; sum += p; }
                        pf[i].x = pg8::pk_fp8x4(sacc[i][0] * pg8::F8_P, sacc[i][1] * pg8::F8_P, sacc[i][2] * pg8::F8_P, sacc[i][3] * pg8::F8_P); pf[i].y = pg8::pk_fp8x4(sacc[i][4] * pg8::F8_P, sacc[i][5] * pg8::F8_P, sacc[i][6] * pg8::F8_P, sacc[i][7] * pg8::F8_P);
                        pf[i].z = pg8::pk_fp8x4(sacc[i][8] * pg8::F8_P, sacc[i][9] * pg8::F8_P, sacc[i][10] * pg8::F8_P, sacc[i][11] * pg8::F8_P); pf[i].w = pg8::pk_fp8x4(sacc[i][12] * pg8::F8_P, sacc[i][13] * pg8::F8_P, sacc[i][14] * pg8::F8_P, sacc[i][15] * pg8::F8_P); }
                    sum = pg8::sum_x32(sum); inv = 1.0f / sum;
#pragma unroll
                    for (int i = 0; i < 8; ++i)
#pragma unroll
                        for (int j = 0; j < 16; ++j) oacc[i][j] = 0.f;
                }
            } else {
                const int vs = s - 2;
#pragma unroll
                for (int blk = 0; blk < 4; ++blk) { const LAS unsigned char* rp = L + bufo + (32 * blk + r) * 256; v4u vf[8];
#pragma unroll
                    for (int i = 0; i < 8; ++i) vf[i] = *(const LAS v4u*)(rp + (((2 * i + hh) ^ fx) << 4));
                    __builtin_amdgcn_sched_barrier(0);
#pragma unroll
                    for (int t = 0; t < 4; ++t) oacc[4 * vs + blk] = mfma8_32x32x64(vf[2 * t], vf[2 * t + 1], pf[2 * t], pf[2 * t + 1], oacc[4 * vs + blk]);
                    __builtin_amdgcn_sched_barrier(0); }
            }
            PT_END(32)
        }
#undef MA_DMA_K
#undef MA_DMA_V
        PT_BEGIN(34)
        asm volatile("s_nop 15\n\ts_nop 15\n\ts_nop 7" ::: "memory");
        __syncthreads();
        LAS unsigned char* stg = L + wid * 4608;
        const float invs = inv * (pg8::F8_O / (pg8::F8_V * pg8::F8_P));
#pragma unroll
        for (int hf = 0; hf < 2; ++hf) {
#pragma unroll
            for (int db = 0; db < 4; ++db)
#pragma unroll
                for (int g = 0; g < 4; ++g) { const f32x16& o = oacc[4 * hf + db];
                    *(LAS unsigned*)(stg + r * 144 + (32 * db + 8 * g + 4 * hh)) = pg8::pk_fp8x4(o[4 * g] * invs, o[4 * g + 1] * invs, o[4 * g + 2] * invs, o[4 * g + 3] * invs); }
#pragma unroll
            for (int it = 0; it < 4; ++it) { const int id = it * 64 + lane, row = id >> 3, ch = id & 7; const v4u v = *(const LAS v4u*)(stg + row * 144 + ch * 16);
                *(v4u*)(O8 + (rowq0 + row) * D + h * MHD + hf * 128 + ch * 16) = v; }
        }
        __syncthreads();
        PT_END(34)
    }
}

__device__ __forceinline__ void chunk_attn_phase(const bf16* PROJ, bf16* MIX, const float* relb, LAS unsigned char* L, int tid, int u0, int ustride PT_PARAM) {
    const int lane = tid & 63, wid = __builtin_amdgcn_readfirstlane(tid >> 6), r = lane & 31, hh = lane >> 5;
    const int tq = (lane & 15) >> 2, tp = lane & 3, tb = (lane >> 4) & 1;
    LAS float* bt = (LAS float*)(L + 98304);
    const float LOG2E = 1.4426950408889634f;
    for (int u = u0; u < BATCH * AT_H * 16; u += ustride) {
        const int qblk = u & 15, h = (u >> 4) & 7, b = u >> 7;
        PT_BEGIN(23)
        for (int i = tid; i < NREL; i += NWAVES * 64) bt[i] = relb[h * NREL + i] * LOG2E - 8.0f;
        const int cq = 4 * qblk + (wid >> 1), qin = 32 * (wid & 1) + r;
        const size_t rowq0 = (size_t)b * SEQ + cq * CHUNK + 32 * (wid & 1);
        bf16x8 qf[4];
        { const bf16* qp = PROJ + (rowq0 + r) * INW + C_AQ + h * AT_D + hh * 8;
#pragma unroll
          for (int ks = 0; ks < 4; ++ks) qf[ks] = *(const bf16x8*)(qp + ks * 16); }
        const int c_lo = (4 * qblk > LEFTC) ? 4 * qblk - LEFTC : 0, nt = 4 * qblk + 4 - c_lo;
        float l = 0.f; f32x16 oacc[2];
#pragma unroll
        for (int j = 0; j < 16; ++j) { oacc[0][j] = 0.f; oacc[1][j] = 0.f; }
#define CA_DMA(ct, bufo) do { const size_t kv0_ = (size_t)b * SEQ + (size_t)(ct) * CHUNK; \
            { const int row_ = 8 * wid + (lane >> 3), ch_ = (lane & 7) ^ (row_ & 7); \
              __builtin_amdgcn_global_load_lds((const unsigned*)(PROJ + (kv0_ + row_) * INW + C_AK + h * AT_D + ch_ * 8), (LAS unsigned*)(L + (bufo) + wid * 1024), 16, 0, 0); } \
            { const int row_ = 16 * (wid & 3) + (lane >> 2); \
              __builtin_amdgcn_global_load_lds((const unsigned*)(PROJ + (kv0_ + row_) * INW + C_AV + h * AT_D + (wid >> 2) * 32 + (lane & 3) * 8), (LAS unsigned*)(L + (bufo) + 8192 + wid * 1024), 16, 0, 0); } } while (0)
        CA_DMA(c_lo, 0); if (nt > 1) CA_DMA(c_lo + 1, 16384);
        PT_END(23)
        int bufo = 0, nbufo = 32768;
        for (int it = 0; it < nt; ++it) {
            const int ct = c_lo + it;
            PT_BEGIN(21)
            if (it + 1 < nt) asm volatile("s_waitcnt vmcnt(2)" ::: "memory"); else asm volatile("s_waitcnt vmcnt(0)" ::: "memory");
            __syncthreads();
            if (it + 2 < nt) CA_DMA(ct + 2, nbufo);
            PT_END(21)
            PT_BEGIN(22)
            const int dist = cq - ct;
            if (dist >= 0 && dist <= LEFTC) {
                f32x16 sb[2];
                { bf16x8 kf[2][4];
#pragma unroll
                  for (int blk = 0; blk < 2; ++blk) { const LAS unsigned char* rp = L + bufo + (32 * blk + r) * 128;
#pragma unroll
                      for (int ks = 0; ks < 4; ++ks) kf[blk][ks] = *(const LAS bf16x8*)(rp + (((2 * ks + hh) ^ (r & 7)) << 4)); }
                  __builtin_amdgcn_sched_barrier(0);
#pragma unroll
                  for (int blk = 0; blk < 2; ++blk) {
#pragma unroll
                      for (int j = 0; j < 16; ++j) sb[blk][j] = 0.f;
#pragma unroll
                      for (int ks = 0; ks < 4; ++ks) sb[blk] = MFMA32(kf[blk][ks], qf[ks], sb[blk]); }
                  __builtin_amdgcn_sched_barrier(0); }
                const float sc = 0.125f * LOG2E;
                if (dist >= 3) { const float bc = bt[2 * MAXREL];
#pragma unroll
                    for (int blk = 0; blk < 2; ++blk)
#pragma unroll
                        for (int j = 0; j < 16; ++j) sb[blk][j] = sb[blk][j] * sc + bc;
                } else { const int rel0 = CHUNK * dist + qin - 4 * hh + MAXREL;
#pragma unroll
                    for (int blk = 0; blk < 2; ++blk)
#pragma unroll
                        for (int j = 0; j < 16; ++j) { int ix = rel0 - 32 * blk - ((j & 3) + 8 * (j >> 2)); ix = ix < 0 ? 0 : (ix > 2 * MAXREL ? 2 * MAXREL : ix); sb[blk][j] = sb[blk][j] * sc + bt[ix]; } }
                float ls = 0.f;
#pragma unroll
                for (int blk = 0; blk < 2; ++blk)
#pragma unroll
                    for (int j = 0; j < 16; ++j) { const float p = __builtin_amdgcn_exp2f(sb[blk][j]); sb[blk][j] = p; ls += p; }
                l += ls;
                bf16x8 pf[2][2];
#pragma unroll
                for (int blk = 0; blk < 2; ++blk) { pf[blk][0] = pack8(sb[blk], 0); pf[blk][1] = pack8(sb[blk], 1); }
                { s16x4 lo[2][4], hi[2][4];
#pragma unroll
                  for (int dblk = 0; dblk < 2; ++dblk)
#pragma unroll
                      for (int q4 = 0; q4 < 4; ++q4) { const LAS unsigned char* vp = L + bufo + 8192 + dblk * 4096 + (32 * (q4 >> 1) + 16 * (q4 & 1) + 4 * hh + tq) * 64 + tb * 32 + tp * 8; lo[dblk][q4] = vtr(vp); hi[dblk][q4] = vtr(vp + 512); }
                  __builtin_amdgcn_sched_barrier(0);
#pragma unroll
                  for (int dblk = 0; dblk < 2; ++dblk)
#pragma unroll
                      for (int q4 = 0; q4 < 4; ++q4) { const bf16x8 a = {lo[dblk][q4][0], lo[dblk][q4][1], lo[dblk][q4][2], lo[dblk][q4][3], hi[dblk][q4][0], hi[dblk][q4][1], hi[dblk][q4][2], hi[dblk][q4][3]};
                          oacc[dblk] = MFMA32(a, pf[q4 >> 1][q4 & 1], oacc[dblk]); }
                  __builtin_amdgcn_sched_barrier(0); }
            }
            PT_END(22)
            bufo = (bufo == 32768) ? 0 : bufo + 16384; nbufo = (nbufo == 32768) ? 0 : nbufo + 16384;
        }
#undef CA_DMA
        PT_BEGIN(24)
        l = pg8::sum_x32(l); const float inv = 1.0f / l;
        LAS unsigned char* stg = L + 49152 + wid * 4608;
#pragma unroll
        for (int dblk = 0; dblk < 2; ++dblk)
#pragma unroll
            for (int g = 0; g < 4; ++g) { const f32x16& o = oacc[dblk]; u32x2 w; w.x = cvtpk_c(o[4 * g] * inv, o[4 * g + 1] * inv); w.y = cvtpk_c(o[4 * g + 2] * inv, o[4 * g + 3] * inv);
                *(LAS u32x2*)(stg + r * 144 + (32 * dblk + 8 * g + 4 * hh) * 2) = w; }
#pragma unroll
        for (int it = 0; it < 4; ++it) { const int id = it * 64 + lane, row = id >> 3, ch = id & 7; const v4u v = *(const LAS v4u*)(stg + row * 144 + ch * 16);
            *(v4u*)(MIX + (rowq0 + row) * D + HG_W + h * AT_D + ch * 8) = v; }
        __syncthreads();
        PT_END(24)
    }
}


constexpr int HL_QH = 0, HL_KH = 32768, HL_V0 = 65536, HL_SIMG = 98304, HL_RED = 131072, HL_GN = 132096, HL_END = 132608;
__device__ __forceinline__ int offb_key(int row) { return ((row & 3) << 2) | ((row >> 2) & 3); }
__device__ __forceinline__ void hgrn_phase(const bf16* PROJ, bf16* MIX, const float* gv, int bh, LAS unsigned char* L, int tid
#if defined(PROBE_SEC)
    , unsigned long long& pt_acc
#endif
    ) {
    const int lane0 = tid & 63, wid = __builtin_amdgcn_readfirstlane(tid >> 6);
    const int b = bh >> 2, h = bh & 3, eb = wid & 3, tb = wid >> 2;
#define HG_LANES() int lane = lane0; asm volatile("" : "+v"(lane)); const int r = lane & 31, hh = lane >> 5, tq = (lane & 15) >> 2, tp = lane & 3, tbit = (lane >> 4) & 1, fx = offb_key(r); \
    (void)r; (void)hh; (void)tq; (void)tp; (void)tbit; (void)fx;
    const float LOG2E = 1.4426950408889634f;
    const bf16* Pb = PROJ + (size_t)b * SEQ * INW;
    const float* gvb = gv + (size_t)(b * NCHUNK) * 1536 + h * HG_D;
    f32x16 st[2];
#pragma unroll
    for (int j = 0; j < 16; ++j) { st[0][j] = 0.f; st[1][j] = 0.f; }
#define HG_DMA(c, ib) do { const bf16* src_ = Pb + (size_t)((c) * CHUNK) * INW; _Pragma("unroll") for (int i_ = 0; i_ < 2; ++i_) { const int row_ = 8 * wid + 4 * i_ + (lane >> 4), cv_ = (lane & 15) ^ offb_key(row_); \
        __builtin_amdgcn_global_load_lds((const unsigned*)(src_ + (size_t)row_ * INW + 256 * h + cv_ * 8), (LAS unsigned*)(L + HL_QH + (ib) * 16384 + (8 * wid + 4 * i_) * 256), 16, 0, 0); \
        __builtin_amdgcn_global_load_lds((const unsigned*)(src_ + (size_t)row_ * INW + 256 * h + 128 + cv_ * 8), (LAS unsigned*)(L + HL_KH + (ib) * 16384 + (8 * wid + 4 * i_) * 256), 16, 0, 0); \
        __builtin_amdgcn_global_load_lds((const unsigned*)(src_ + (size_t)row_ * INW + C_HI + h * HG_D + cv_ * 8), (LAS unsigned*)(L + HL_V0 + (ib) * 16384 + (8 * wid + 4 * i_) * 256), 16, 0, 0); } } while (0)
    { HG_LANES();
      HG_DMA(0, 0);
      unsigned z_ = 0u; asm volatile("" : "+v"(z_));
      for (int i = tid; i < 32768 / 16; i += NWAVES * 64) *(LAS v4u*)(L + HL_SIMG + i * 16) = (v4u){z_, z_, z_, z_}; }
    asm volatile("s_waitcnt vmcnt(0)" ::: "memory"); __syncthreads();
    for (int c = 0; c < NCHUNK; ++c) {
        const int ib = c & 1, vb = HL_V0 + ib * 16384, qb = HL_QH + ib * 16384, kb_ = HL_KH + ib * 16384;
        HG_LANES();
        PT_BEGIN(1)
        if (c + 1 < NCHUNK) HG_DMA(c + 1, (c + 1) & 1);
        u32x2 gw[4]; float g1[2], g2[2], em[2];
        { const bf16* gp = Pb + (size_t)(c * CHUNK + 32 * tb + r) * INW + C_HGT + h * HG_D + 32 * eb + 4 * hh;
#pragma unroll
          for (int g = 0; g < 4; ++g) gw[g] = *(const u32x2*)(gp + 8 * g);
          const int cn = (c + 1 < NCHUNK) ? c + 1 : c;
#pragma unroll
          for (int k2 = 0; k2 < 2; ++k2) { const int d = 32 * (2 * tb + k2) + r; g1[k2] = gvb[(size_t)c * 1536 + d]; g2[k2] = gvb[(size_t)c * 1536 + 512 + d]; em[k2] = gvb[(size_t)cn * 1536 + 1024 + d]; } }
        PT_END(1)
        PT_BEGIN(2)
        f32x16 at[2]; bf16x8 qfr[8];
        { const LAS unsigned char* qp = L + qb + (32 * tb + r) * 256;
#pragma unroll
          for (int ks = 0; ks < 8; ++ks) qfr[ks] = *(const LAS bf16x8*)(qp + (((2 * ks + hh) ^ fx) << 4)); }
#pragma unroll
        for (int sb = 0; sb < 2; ++sb) { if (sb <= tb) { bf16x8 kfr[8];
            const LAS unsigned char* kp = L + kb_ + (32 * sb + r) * 256;
#pragma unroll
            for (int ks = 0; ks < 8; ++ks) kfr[ks] = *(const LAS bf16x8*)(kp + (((2 * ks + hh) ^ fx) << 4));
            __builtin_amdgcn_sched_barrier(0);
#pragma unroll
            for (int j = 0; j < 16; ++j) at[sb][j] = 0.f;
#pragma unroll
            for (int ks = 0; ks < 8; ++ks) at[sb] = MFMA32(kfr[ks], qfr[ks], at[sb]);
            __builtin_amdgcn_sched_barrier(0);
            if (sb == tb) {
#pragma unroll
                for (int j = 0; j < 16; ++j) at[sb][j] = (crow16(j, hh) <= r) ? at[sb][j] : 0.f; } } }
        f32x16 oacc;
#pragma unroll
        for (int j = 0; j < 16; ++j) oacc[j] = 0.f;
        { s16x4 lo[8], hi[8];
#pragma unroll
          for (int ks = 0; ks < 8; ++ks) { const int row0 = 16 * ks + 8 * hh;
              const int ra = row0 + tq, rb = row0 + 4 + tq, ch = 4 * eb + 2 * tbit + (tp >> 1);
              lo[ks] = vtr(L + HL_SIMG + ra * 256 + ((ch ^ offb_key(ra)) << 4) + 8 * (tp & 1)); hi[ks] = vtr(L + HL_SIMG + rb * 256 + ((ch ^ offb_key(rb)) << 4) + 8 * (tp & 1)); }
          __builtin_amdgcn_sched_barrier(0);
#pragma unroll
          for (int ks = 0; ks < 8; ++ks) { const bf16x8 a = {lo[ks][0], lo[ks][1], lo[ks][2], lo[ks][3], hi[ks][0], hi[ks][1], hi[ks][2], hi[ks][3]}; oacc = MFMA32(a, qfr[ks], oacc); }
          __builtin_amdgcn_sched_barrier(0); }
        { s16x4 lo[4], hi[4];
#pragma unroll
          for (int q4 = 0; q4 < 4; ++q4) { if ((q4 >> 1) <= tb) { const int row0 = 32 * (q4 >> 1) + 16 * (q4 & 1) + 4 * hh;
              const int ra = row0 + tq, rb = row0 + 8 + tq, ch = 4 * eb + 2 * tbit + (tp >> 1);
              lo[q4] = vtr(L + vb + ra * 256 + ((ch ^ offb_key(ra)) << 4) + 8 * (tp & 1)); hi[q4] = vtr(L + vb + rb * 256 + ((ch ^ offb_key(rb)) << 4) + 8 * (tp & 1)); } }
          __builtin_amdgcn_sched_barrier(0);
#pragma unroll
          for (int q4 = 0; q4 < 4; ++q4) { if ((q4 >> 1) <= tb) { const bf16x8 a = {lo[q4][0], lo[q4][1], lo[q4][2], lo[q4][3], hi[q4][0], hi[q4][1], hi[q4][2], hi[q4][3]};
              oacc = MFMA32(a, pack8(at[q4 >> 1], q4 & 1), oacc); } }
          __builtin_amdgcn_sched_barrier(0); }
        { float ss = 0.f;
#pragma unroll
          for (int j = 0; j < 16; ++j) ss += oacc[j] * oacc[j];
          ss = pg8::sum_x32(ss);
          if (hh == 0) *(LAS float*)(L + HL_RED + ((tb * 4 + eb) * 32 + r) * 4) = ss; }
        { s16x4 vlo[4], vhi[4], klo[2][4], khi[2][4];
#pragma unroll
          for (int ks = 0; ks < 4; ++ks) { const int row0 = 16 * ks + 8 * hh, ra = row0 + tq, rb = row0 + 4 + tq, ch = 4 * eb + 2 * tbit + (tp >> 1);
              vlo[ks] = vtr(L + vb + ra * 256 + ((ch ^ offb_key(ra)) << 4) + 8 * (tp & 1)); vhi[ks] = vtr(L + vb + rb * 256 + ((ch ^ offb_key(rb)) << 4) + 8 * (tp & 1));
#pragma unroll
              for (int k2 = 0; k2 < 2; ++k2) { const int chk = 4 * (2 * tb + k2) + 2 * tbit + (tp >> 1);
                  klo[k2][ks] = vtr(L + kb_ + ra * 256 + ((chk ^ offb_key(ra)) << 4) + 8 * (tp & 1)); khi[k2][ks] = vtr(L + kb_ + rb * 256 + ((chk ^ offb_key(rb)) << 4) + 8 * (tp & 1)); } }
          __builtin_amdgcn_sched_barrier(0);
#pragma unroll
          for (int k2 = 0; k2 < 2; ++k2) { f32x16 tt;
#pragma unroll
              for (int j = 0; j < 16; ++j) tt[j] = 0.f;
#pragma unroll
              for (int ks = 0; ks < 4; ++ks) { const bf16x8 va = {vlo[ks][0], vlo[ks][1], vlo[ks][2], vlo[ks][3], vhi[ks][0], vhi[ks][1], vhi[ks][2], vhi[ks][3]};
                  const bf16x8 kf = {klo[k2][ks][0], klo[k2][ks][1], klo[k2][ks][2], klo[k2][ks][3], khi[k2][ks][0], khi[k2][ks][1], khi[k2][ks][2], khi[k2][ks][3]};
                  tt = MFMA32(va, kf, tt); }
#pragma unroll
              for (int j = 0; j < 16; ++j) st[k2][j] = g1[k2] * st[k2][j] + g2[k2] * tt[j]; } }
        PT_END(2)
        PT_BEGIN(3)
        asm volatile("s_waitcnt vmcnt(0)" ::: "memory"); __syncthreads(); PT_END(3) PT_BEGIN(4)
        { float ss = 0.f;
#pragma unroll
          for (int k = 0; k < 4; ++k) ss += *(const LAS float*)(L + HL_RED + ((tb * 4 + k) * 32 + r) * 4);
          const float rs = 1.0f / sqrtf(ss * (1.0f / 128.0f) + EPS);
          bf16* op = MIX + ((size_t)b * SEQ + c * CHUNK + 32 * tb + r) * D + h * HG_D + 32 * eb + 4 * hh;
#pragma unroll
          for (int g = 0; g < 4; ++g) { u32x2 w; w.x = cvtpk_c(oacc[4 * g] * rs * bflo(gw[g].x), oacc[4 * g + 1] * rs * bfhi(gw[g].x)); w.y = cvtpk_c(oacc[4 * g + 2] * rs * bflo(gw[g].y), oacc[4 * g + 3] * rs * bfhi(gw[g].y));
              *(u32x2*)(op + 8 * g) = w; } }
        if (c + 1 < NCHUNK) {
#pragma unroll
            for (int k2 = 0; k2 < 2; ++k2) { const int drow = 32 * (2 * tb + k2) + r; const float e_ = em[k2];
#pragma unroll
                for (int g = 0; g < 4; ++g) { u32x2 w; w.x = cvtpk_c(st[k2][4 * g] * e_, st[k2][4 * g + 1] * e_); w.y = cvtpk_c(st[k2][4 * g + 2] * e_, st[k2][4 * g + 3] * e_);
                    *(LAS u32x2*)(L + HL_SIMG + drow * 256 + (((4 * eb + g) ^ fx) << 4) + 8 * hh) = w; } }
        }
        __syncthreads();
        PT_END(4)
    }
#undef HG_LANES
#undef HG_DMA
}
#ifndef WGM_IN
#define WGM_IN 4
#endif
#ifndef WGM_N1K
#define WGM_N1K 4
#endif
#ifndef WGM_FFNUP
#define WGM_FFNUP 4
#endif
#ifndef WGM_MOEUP
#define WGM_MOEUP 4
#endif
#ifndef WGM_MOEDN
#define WGM_MOEDN 4
#endif
#ifndef F8_DENSE_FROM
#define F8_DENSE_FROM 1
#endif
#ifndef SKEW_SKIP
#define SKEW_SKIP 3
#endif
#ifndef STG_N1024
#define STG_N1024 0
#endif
#ifndef STG_FFN
#define STG_FFN 0
#endif
#ifndef STG_MOE
#define STG_MOE 0
#endif

__device__ __forceinline__ void route1(const unsigned char* H, unsigned char* xq, const float* nffn, const float* wr, unsigned* toke, float* tokg, float* tokrs, gu32* cnt, LAS unsigned* lcnt, int w0, int nw, int lane, int tid) {
    if (tid < 16) lcnt[tid] = 0u;
    __syncthreads();
    float wg[16][8];
#pragma unroll
    for (int gq = 0; gq < 2; ++gq) { const int k0 = 8 * (64 * gq + lane);
#pragma unroll
        for (int jj = 0; jj < 8; ++jj) { const float gn = nffn[k0 + jj]; const f32x4 w0v = *(const f32x4*)(wr + (size_t)(k0 + jj) * NE), w1v = *(const f32x4*)(wr + (size_t)(k0 + jj) * NE + 4);
            wg[8 * gq + jj][0] = gn * w0v.x; wg[8 * gq + jj][1] = gn * w0v.y; wg[8 * gq + jj][2] = gn * w0v.z; wg[8 * gq + jj][3] = gn * w0v.w;
            wg[8 * gq + jj][4] = gn * w1v.x; wg[8 * gq + jj][5] = gn * w1v.y; wg[8 * gq + jj][6] = gn * w1v.z; wg[8 * gq + jj][7] = gn * w1v.w; } }
    v4u nh[2], nl[2];
#pragma unroll
    for (int gq = 0; gq < 2; ++gq) { const unsigned char* p = H + (size_t)(w0 < M ? w0 : 0) * 4096 + (64 * gq + lane) * 16; nh[gq] = *(const v4u*)p; nl[gq] = (v4u){0u, 0u, 0u, 0u}; }
    for (int tok = w0; tok < M; tok += nw) {
        float a[8] = {0.f, 0.f, 0.f, 0.f, 0.f, 0.f, 0.f, 0.f}; float ss = 0.f;
        v4u ch[2], cl[2];
#pragma unroll
        for (int gq = 0; gq < 2; ++gq) { ch[gq] = nh[gq]; cl[gq] = nl[gq]; }
        { const int tn = (tok + nw < M) ? tok + nw : tok;
#pragma unroll
          for (int gq = 0; gq < 2; ++gq) { const unsigned char* p = H + (size_t)tn * 4096 + (64 * gq + lane) * 16; nh[gq] = *(const v4u*)p; nl[gq] = (v4u){0u, 0u, 0u, 0u}; } }
#pragma unroll
        for (int gq = 0; gq < 2; ++gq) { const v4u A = ch[gq], C = cl[gq];
            const float hv[8] = {__uint_as_float(A.x << 16) + __uint_as_float(C.x << 16), __uint_as_float(A.x & 0xffff0000u) + __uint_as_float(C.x & 0xffff0000u), __uint_as_float(A.y << 16) + __uint_as_float(C.y << 16), __uint_as_float(A.y & 0xffff0000u) + __uint_as_float(C.y & 0xffff0000u),
                                 __uint_as_float(A.z << 16) + __uint_as_float(C.z << 16), __uint_as_float(A.z & 0xffff0000u) + __uint_as_float(C.z & 0xffff0000u), __uint_as_float(A.w << 16) + __uint_as_float(C.w << 16), __uint_as_float(A.w & 0xffff0000u) + __uint_as_float(C.w & 0xffff0000u)};
#pragma unroll
            for (int jj = 0; jj < 8; ++jj) { const float x = hv[jj]; ss += x * x;
#pragma unroll
                for (int e = 0; e < 8; ++e) a[e] += x * wg[8 * gq + jj][e]; } }
        ss = wave_sum(ss);
#pragma unroll
        for (int e = 0; e < 8; ++e) a[e] = wave_sum(a[e]);
        const float rs = 1.0f / sqrtf(ss * (1.0f / 1024.0f) + EPS);
        int e1 = 0; float l1 = a[0];
#pragma unroll
        for (int e = 1; e < 8; ++e) if (a[e] > l1) { l1 = a[e]; e1 = e; }
        int e2 = -1; float l2 = -3.0e38f;
#pragma unroll
        for (int e = 0; e < 8; ++e) if (e != e1 && a[e] > l2) { l2 = a[e]; e2 = e; }
        const float g1 = 1.0f / (1.0f + __expf((l2 - l1) * rs)), g2 = 1.0f - g1;
#pragma unroll
        for (int gq = 0; gq < 2; ++gq) { const v4u A = ch[gq]; u32x2 w;
            w.x = pg8::pk_fp8x4(__uint_as_float(A.x << 16) * rs, __uint_as_float(A.x & 0xffff0000u) * rs, __uint_as_float(A.y << 16) * rs, __uint_as_float(A.y & 0xffff0000u) * rs);
            w.y = pg8::pk_fp8x4(__uint_as_float(A.z << 16) * rs, __uint_as_float(A.z & 0xffff0000u) * rs, __uint_as_float(A.w << 16) * rs, __uint_as_float(A.w & 0xffff0000u) * rs);
            *(GAS u32x2*)(xq + (size_t)tok * 1024 + (64 * gq + lane) * 8) = w; }
        if (lane == 0) { toke[tok] = (unsigned)e1 | ((unsigned)e2 << 8); tokg[2 * tok] = g1; tokg[2 * tok + 1] = g2; tokrs[tok] = rs;
            __hip_atomic_fetch_add(lcnt + e1, 1u, __ATOMIC_RELAXED, __HIP_MEMORY_SCOPE_WORKGROUP); __hip_atomic_fetch_add(lcnt + 8 + e2, 1u, __ATOMIC_RELAXED, __HIP_MEMORY_SCOPE_WORKGROUP); }
    }
    __syncthreads();
    if (tid < 16) { const unsigned v = lcnt[tid]; if (v) __hip_atomic_fetch_add(cnt + tid, v, RLX_AGENT); }
}
__device__ __forceinline__ void route2(const unsigned* toke, const float* tokg, const float* tokrs, gu32* cnt, gu32* cur, int* row_tok, float* row_gate, float* row_rs, int* tok_row0, LAS unsigned* lw, int wg, int nwg, int tid) {
    const int lane = tid & 63, wave = tid >> 6;
    unsigned pst[2][8];
#pragma unroll
    for (int k = 0; k < 2; ++k) { unsigned acc = 0u;
#pragma unroll
        for (int e = 0; e < 8; ++e) { pst[k][e] = acc; acc += ((__hip_atomic_load(cnt + k * 8 + e, RLX_AGENT) + 255u) >> 8) << 8; } }
    for (int base = wg * 256; base < M; base += nwg * 256) {
        const int tok = base + (tid & 255); unsigned te = 0u; float rs = 0.f; unsigned long long mk[2][8];
        if (wave < 4) { te = toke[tok]; rs = tokrs[tok];
#pragma unroll
            for (int k = 0; k < 2; ++k) { const int e = (int)((te >> (8 * k)) & 255u);
#pragma unroll
                for (int ee = 0; ee < 8; ++ee) { mk[k][ee] = __ballot(e == ee); if (lane == 0) lw[wave * 16 + k * 8 + ee] = (unsigned)__popcll(mk[k][ee]); } } }
        __syncthreads();
        if (tid < 16) { unsigned c0 = lw[tid], c1 = lw[16 + tid], c2 = lw[32 + tid], c3 = lw[48 + tid]; const unsigned tot = c0 + c1 + c2 + c3;
            const unsigned b = tot ? __hip_atomic_fetch_add(cur + tid, tot, RLX_AGENT) : 0u;
            lw[64 + tid] = b; lw[80 + tid] = b + c0; lw[96 + tid] = b + c0 + c1; lw[112 + tid] = b + c0 + c1 + c2; }
        __syncthreads();
        if (wave < 4) {
#pragma unroll
            for (int k = 0; k < 2; ++k) { const int e = (int)((te >> (8 * k)) & 255u); unsigned row = 0u;
#pragma unroll
                for (int ee = 0; ee < 8; ++ee) if (e == ee) row = pst[k][ee] + lw[64 + wave * 16 + k * 8 + ee] + (unsigned)__popcll(mk[k][ee] & ((1ull << lane) - 1ull));
                row_tok[(size_t)k * ROWS_PAD + row] = tok; row_gate[(size_t)k * ROWS_PAD + row] = tokg[2 * tok + k]; row_rs[(size_t)k * ROWS_PAD + row] = rs; if (k == 0) tok_row0[tok] = (int)row; } }
        __syncthreads();
    }
}
__device__ __forceinline__ int moe_panels(gu32* cntk, LAS int* pexp, int tid) {
    int pp = 0, ex = 0;
#pragma unroll
    for (int e = 0; e < 8; ++e) { const int n = (int)((__hip_atomic_load(cntk + e, RLX_AGENT) + 255u) >> 8); if (tid >= pp && tid < pp + n) ex = e; pp += n; }
    if (tid < pp && tid < MAXPANEL) pexp[tid] = ex;
    __syncthreads();
    return pp;
}

#if defined(PROBE_SEC)
#define PT_ARG , pt_acc
#else
#define PT_ARG
#endif
__device__ __forceinline__ void stagger_delay(int bx, int ticks  ) {
    if (ticks > 0 && (bx & 1)) { const unsigned long long t0 = __builtin_amdgcn_s_memrealtime(); while (__builtin_amdgcn_s_memrealtime() - t0 < (unsigned long long)ticks) __builtin_amdgcn_s_sleep(4); }
}
__device__ __forceinline__ void sub_barrier(gu32* cnt, unsigned n, int tid) {
    asm volatile("s_waitcnt vmcnt(0)" ::: "memory");
    __syncthreads();
    if (tid == 0) {
        __builtin_amdgcn_fence(__ATOMIC_RELEASE, "agent");
        asm volatile("s_waitcnt vmcnt(0)" ::: "memory");
        __hip_atomic_fetch_add(cnt, 1u, RLX_AGENT);
        unsigned sp = 0u;
        while (__hip_atomic_load(cnt, RLX_AGENT) < n) { __builtin_amdgcn_s_sleep(2); if (++sp > (1u << 22)) break; }
        __builtin_amdgcn_fence(__ATOMIC_ACQUIRE, "agent");
        asm volatile("s_waitcnt vmcnt(0)" ::: "memory");
    }
    __syncthreads();
}
__global__ void __launch_bounds__(NWAVES * 64, 2) fwd(Args args) {
    extern __shared__ __attribute__((aligned(16))) unsigned char lds[];
    LAS unsigned char* L = (LAS unsigned char*)lds;
    volatile LAS unsigned* MISC = (volatile LAS unsigned*)(L + MISC_OFF);
    { const int t0 = threadIdx.x; for (int u = t0; u < (LDS_BYTES - LDSCTL_OFF) / 4; u += NWAVES * 64) ((LAS unsigned*)(L + LDSCTL_OFF))[u] = 0u; }
    __syncthreads();
    XcdBarrier bar = xcd_barrier_post((unsigned*)((gu32*)(args.ws + WS_CTL)) + CW_BAR, MISC + 8);
    const int lo = args.ph_lo, hi = args.ph_hi; int ph = 0;
    const int wave_s = __builtin_amdgcn_readfirstlane((int)threadIdx.x >> 6);
#if defined(PROBE_SEC)
    unsigned long long pt_acc = 0ull;
#endif
#define PH_BEGIN if (ph >= lo && ph < hi) { int zk_ = 0; asm volatile("" : "+s"(zk_));   unsigned z0_ = 0u; asm volatile("" : "+s"(z0_)); int tid = wave_s * 64 + (int)__builtin_amdgcn_mbcnt_hi(~0u, __builtin_amdgcn_mbcnt_lo(~0u, z0_)); asm volatile("" : "+v"(tid));     GAS unsigned char* wsg_ = (GAS unsigned char*)args.ws; asm volatile("" : "+s"(wsg_)); unsigned char* ws = (unsigned char*)wsg_; \
    int G = gridDim.x; asm volatile("" : "+s"(G)); const int bx = blockIdx.x, vcu = (G % 8 == 0) ? (bx % 8) * (G / 8) + bx / 8 : bx, ngw = G * NWAVES; (void)ngw; \
    const int lane = tid & 63, wave = __builtin_amdgcn_readfirstlane(tid >> 6), gw = vcu * NWAVES + wave; (void)lane; (void)gw; gu32* ctl = (gu32*)(ws + WS_CTL); (void)ctl;
#define PH_END   if (ph + 1 < hi) { XcdBarrier b2_ = bar; GAS unsigned* p2_ = (GAS unsigned*)bar.bar; asm volatile("" : "+s"(p2_)); b2_.bar = (unsigned*)p2_; unsigned z1_ = 0u; asm volatile("" : "+s"(z1_)); xcd_barrier(b2_, wave_s * 64 + (int)__builtin_amdgcn_mbcnt_hi(~0u, __builtin_amdgcn_mbcnt_lo(~0u, z1_))); } } ++ph;
#define TID_FRESH() ({ unsigned zt_ = 0u; asm volatile("" : "+s"(zt_)); int t_ = wave_s * 64 + (int)__builtin_amdgcn_mbcnt_hi(~0u, __builtin_amdgcn_mbcnt_lo(~0u, zt_)); asm volatile("" : "+v"(t_)); t_; })
#define SS   ((float*)(ws + WS_SS))
#define SSM  ((float*)(ws + WS_SSM))
#define MIX  ((bf16*)(ws + WS_MIX))
#define BIG  ((bf16*)(ws + WS_BIG))
#define MB   ((bf16*)(ws + WS_MB))
#define KV   ((bf16*)(ws + WS_KV))
#define OUT  (args.out)
#define STR  ((unsigned char*)args.out)
#define LBT  ((float*)(ws + WS_RT + RT_LB))
#define VTB  (ws + WS_HB + 64 * MiB)
#define XQ   (ws + WS_HB)
#define PR_OUT ((args.flags & 4) ? (unsigned char*)(ws + WS_HB) : STR)
#define PR_SS  ((args.flags & 4) ? (float*)(ws + WS_WM + 160 * MiB) : SS)
#define WL   (ws + WS_W + (size_t)l * W_LAYER)
#define WF   (ws + WS_W + W_FFN + (size_t)(l >> 1) * W_FFN_STRIDE)

    PH_BEGIN
    {   LAS unsigned* scr = (LAS unsigned*)(L + wave * 16384); int rot = 0;
        for (int l = 0; l < DEPTH; ++l) {
            cvt_matrix(args.in[(I_WIN) + zk_] + (size_t)l * D * INW, args.in[(I_WIN) + zk_] + (size_t)l * D * INW + 512, D, INW, 1024, (bf16*)(WL + W_IN), args.in[(I_NMIX) + zk_] + l * D, scr, lane, rot, gw, ngw);
            cvt_matrix(args.in[(I_WIN) + zk_] + (size_t)l * D * INW + 1024, nullptr, D, INW, INW - 1024, (bf16*)(WL + W_IN) + (size_t)1024 * D, args.in[(I_NMIX) + zk_] + l * D, scr, lane, rot, gw, ngw);
            cvt_matrix(args.in[(I_WOUT) + zk_] + (size_t)l * D * D, nullptr, D, D, D, (bf16*)(WL + W_OUT), nullptr, scr, lane, rot, gw, ngw);
            cvt_matrix8(args.in[(I_WMQ) + zk_] + (size_t)l * D * D, nullptr, D, D, D, WL + W_MQ, args.in[(I_NMQ) + zk_] + l * D, pg8::F8_WGU, scr, lane, rot, gw, ngw);
            cvt_matrix(args.in[(I_WMKV) + zk_] + (size_t)l * D * 2048, nullptr, D, 2048, 2048, (bf16*)(ws + WS_W + W_KV) + (size_t)l * 2048 * D, args.in[(I_NMKV) + zk_] + l * D, scr, lane, rot, gw, ngw);
            cvt_matrix8(args.in[(I_WMO) + zk_] + (size_t)l * D * D, nullptr, D, D, D, WL + W_MO, nullptr, pg8::F8_WMO, scr, lane, rot, gw, ngw); }
        for (int j = 0; j < 2; ++j) { unsigned char* wfj = ws + WS_W + W_FFN + (size_t)j * W_FFN_STRIDE;
            if (j < F8_DENSE_FROM) {
            cvt_matrix(args.in[(I_WG) + zk_] + (size_t)j * D * FF, args.in[(I_WU) + zk_] + (size_t)j * D * FF, D, FF, 2 * FF, (bf16*)(wfj + W_FFN_GU), args.in[(I_NFFN) + zk_] + (2 * j) * D, scr, lane, rot, gw, ngw);
            cvt_matrix8(args.in[(I_WD) + zk_] + (size_t)j * FF * D, nullptr, FF, D, D, wfj + W_FFN_D, nullptr, pg8::F8_WD, scr, lane, rot, gw, ngw);
            } else {
            cvt_matrix8(args.in[(I_WG) + zk_] + (size_t)j * D * FF, args.in[(I_WU) + zk_] + (size_t)j * D * FF, D, FF, 2 * FF, wfj + W_FFN_GU, args.in[(I_NFFN) + zk_] + (2 * j) * D, pg8::F8_WGU, scr, lane, rot, gw, ngw);
            cvt_matrix8(args.in[(I_WD) + zk_] + (size_t)j * FF * D, nullptr, FF, D, D, wfj + W_FFN_D, nullptr, pg8::F8_WD, scr, lane, rot, gw, ngw); } }
        for (int r0 = gw; r0 < M; r0 += 4 * ngw) {
            f32x4 xa[4][2][2];
#pragma unroll
            for (int q = 0; q < 4; ++q) { const int r = (r0 + q * ngw < M) ? r0 + q * ngw : r0; const float* xr = args.in[(I_X) + zk_] + (size_t)r * D;
#pragma unroll
                for (int gq = 0; gq < 2; ++gq) { xa[q][gq][0] = *(const GAS f32x4*)(xr + 8 * (64 * gq + lane)); xa[q][gq][1] = *(const GAS f32x4*)(xr + 8 * (64 * gq + lane) + 4); } }
#pragma unroll
            for (int q = 0; q < 4; ++q) { const int r = r0 + q * ngw; if (r < M) { float s = 0.f;
#pragma unroll
                for (int gq = 0; gq < 2; ++gq) { const float hv[8] = {xa[q][gq][0].x, xa[q][gq][0].y, xa[q][gq][0].z, xa[q][gq][0].w, xa[q][gq][1].x, xa[q][gq][1].y, xa[q][gq][1].z, xa[q][gq][1].w};
#pragma unroll
                    for (int j = 0; j < 8; ++j) s += hv[j] * hv[j];
                    pg8::hl_store8(STR + (size_t)r * 4096 + (64 * gq + lane) * 16, hv); }
                s = wave_sum(s); if (lane < 16) SS[(size_t)r * 16 + lane] = lane == 0 ? s : 0.f; } } }
        for (int r = gw; r < MROWS; r += ngw) { const float s = row_to_bf16(args.in[(I_MEM) + zk_] + (size_t)r * D, MB + (size_t)r * D, lane); if (lane < 16) SSM[(size_t)r * 16 + lane] = lane == 0 ? s : 0.f; }
        for (int i = gw * 64 + lane; i < HG_W; i += ngw * 64) { const float* lbp = args.in[(I_LB) + zk_] + i; const float a0 = lbp[0], a1 = lbp[512], a2 = lbp[1024], a3 = lbp[1536];
            const float mx = fmaxf(fmaxf(a0, a1), fmaxf(a2, a3)); const float e0 = __expf(a0 - mx), e1 = __expf(a1 - mx), e2 = __expf(a2 - mx), e3 = __expf(a3 - mx); const float inv = 1.0f / (e0 + e1 + e2 + e3);
            LBT[i] = 0.f; LBT[512 + i] = e1 * inv; LBT[1024 + i] = (e1 + e2) * inv; LBT[1536 + i] = (e1 + e2 + e3) * inv; }
    }
    PH_END


    for (int l = 0; l < DEPTH; ++l) {
        PH_BEGIN
        {   pg8::DenseOrderHL S; S.init(M / 256, INW / 256, G, bx, STR, WL + W_IN, D, WGM_IN);
            pg8::EpiInProj E{BIG, INW, SS, LBT + l * HG_W, (float*)(ws + WS_GV), args.in[(I_HGAIN) + zk_] + l * HG_W};
            pg8::gemm_phase<pg8::EpiInProj, pg8::DenseOrderHL, true, true>(L, D, S, E, tid PT_ARG); }
        PH_END
        PH_BEGIN
        {
            if (bx < 64) { if (!(args.flags & 32)) hgrn_phase(BIG, MIX, (const float*)(ws + WS_GV), bx, L, tid PT_ARG); }
            else { if (!(args.flags & 16)) chunk_attn_phase(BIG, MIX, args.in[(I_RELB) + zk_] + (size_t)l * AT_H * NREL, L, tid, bx - 64, G - 64 PT_ARG);
                if (l == 0 && !(args.flags & (16 | 32))) {
                    __syncthreads();
                    pg8::DenseOrder S; S.init(MROWS / 256, DEPTH * 2048 / 256, G - 64, bx - 64, MB, ws + WS_W + W_KV, D);
                    pg8::EpiRowScale E{KV, DEPTH * 2048, SSM, 1.0f, 2};
                    pg8::gemm_phase<pg8::EpiRowScale, pg8::DenseOrder, true, true>(L, D, S, E, TID_FRESH() PT_ARG); }
                if (!(args.flags & (16 | 32))) { const int lm = l | 1, jm = lm >> 1, e0 = (l & 1) * 4; LAS unsigned* scr = (LAS unsigned*)(L + wave * 16384); int rot = 0;
                    const int cw = (bx - 64) * NWAVES + wave, ncw = (G - 64) * NWAVES;
                    for (int e = e0; e < e0 + 4; ++e) { unsigned char* we = ws + WS_WM + (size_t)e * WM_ESTRIDE; const size_t eo = (size_t)(jm * NE + e) * D * FFE;
                        cvt_matrix8(args.in[(I_EG) + zk_] + eo, args.in[(I_EU) + zk_] + eo, D, FFE, 2 * FFE, we + WM_GU, args.in[(I_NFFN) + zk_] + lm * D, pg8::F8_WGU, scr, lane, rot, cw, ncw);
                        cvt_matrix8(args.in[(I_ED) + zk_] + eo, nullptr, FFE, D, D, we + WM_D, nullptr, pg8::F8_WD, scr, lane, rot, cw, ncw); } }
            } }
        PH_END
        PH_BEGIN
        post_rows(MIX, args.in[(I_AGAIN) + zk_] + l * AT_W, gw, ngw, lane);
        if (l == 0) vt_pass(KV, VTB, bx, G, tid);
        PH_END
        PH_BEGIN
        {   pg8::DenseOrder S; S.init(M / 256, D / 256, G, bx, MIX, WL + W_OUT, D, WGM_N1K);
            pg8::EpiResid E{STR, PR_OUT, PR_SS, (args.flags & 4) ? nullptr : XQ, 1.0f};
            pg8::gemm_phase<pg8::EpiResid, pg8::DenseOrder, true, true>(L, D, S, E, tid PT_ARG); }
        PH_END
        PH_BEGIN
        {   pg8::DenseOrder8 S; S.init(M / 256, D / 256, G, bx, XQ, WL + W_MQ, D / 2, WGM_N1K);
            pg8::EpiRowScale E{BIG, D, SS, pg8::F8_Q / pg8::F8_WGU, 1};
            pg8::gemm_phase<pg8::EpiRowScale, pg8::DenseOrder8, true, true>(L, D / 2, S, E, tid PT_ARG); }
        PH_END
        PH_BEGIN
        mem_attn_phase((const unsigned char*)BIG, KV, VTB, (unsigned char*)(BIG + (size_t)M * D), l, L, tid, vcu, G PT_ARG);
        PH_END
        PH_BEGIN
        {   pg8::DenseOrder8 S; S.init(M / 256, D / 256, G, bx, BIG + (size_t)M * D, WL + W_MO, D / 2, WGM_N1K);
            pg8::EpiResid E{STR, PR_OUT, PR_SS, ((l & 1) || (l >> 1) < F8_DENSE_FROM || (args.flags & 4)) ? nullptr : XQ, 1.0f / (pg8::F8_O * pg8::F8_WMO)};
            pg8::gemm_phase<pg8::EpiResid, pg8::DenseOrder8, true, true>(L, D / 2, S, E, tid PT_ARG); }
        PH_END
        if ((l & 1) == 0) {
            PH_BEGIN
            if ((l >> 1) < F8_DENSE_FROM) {
                pg8::DenseOrderHL S; S.init(M / 256, 2 * FF / 256, G, bx, STR, WF + W_FFN_GU, D, WGM_FFNUP);
                pg8::EpiSwiglu8<true, false> E{(unsigned char*)BIG, FF, SS};
                pg8::gemm_phase<pg8::EpiSwiglu8<true, false>, pg8::DenseOrderHL, true, true>(L, D, S, E, TID_FRESH() PT_ARG);
            } else {   pg8::DenseOrder8 S; S.init(M / 256, 2 * FF / 256, G, bx, XQ, WF + W_FFN_GU, D / 2, WGM_FFNUP);
                pg8::EpiSwiglu8<true> E{(unsigned char*)BIG, FF, SS};
                pg8::gemm_phase<pg8::EpiSwiglu8<true>, pg8::DenseOrder8, true, true>(L, D / 2, S, E, TID_FRESH() PT_ARG); }
            PH_END
            PH_BEGIN
            {   pg8::DenseOrder8 S; S.init(M / 256, D / 256, G, bx, BIG, WF + W_FFN_D, FF / 2, WGM_N1K);
                pg8::EpiResid E{STR, PR_OUT, PR_SS, nullptr, 1.0f / (pg8::F8_WD * pg8::F8_ACT)};
                pg8::gemm_phase<pg8::EpiResid, pg8::DenseOrder8, true, true>(L, FF / 2, S, E, tid PT_ARG); }
            PH_END
        } else {
            const int j = l >> 1;
#define CNT      (ctl + CW_MOE + j * 64)
#define CUR      (CNT + 32)
#define TOKE     ((unsigned*)(ws + WS_RT + RT_TOKE))
#define TOKG     ((float*)(ws + WS_RT + RT_TOKG))
#define TOKRS    ((float*)(ws + WS_RT + RT_TOKRS))
#define ROW_TOK  ((int*)(ws + WS_RT + RT_ROWTOK))
#define ROW_GATE ((float*)(ws + WS_RT + RT_ROWGATE))
#define ROW_RS   ((float*)(ws + WS_RT + RT_ROWRS))
#define PEXP     ((LAS int*)(L + PEXP_OFF))
#define TOK_ROW0 ((int*)(ws + WS_RT + RT_TOKROW0))
#define Y0BUF    ((bf16*)(ws + WS_MIX))
            PH_BEGIN
            {   if (!(args.flags & 1)) route1(STR, XQ, args.in[(I_NFFN) + zk_] + l * D, args.in[(I_WR) + zk_] + (size_t)j * D * NE, TOKE, TOKG, TOKRS, CNT, (LAS unsigned*)(L + LDSCTL_OFF), gw, ngw, lane, tid);
                for (int i = gw * 64 + lane; i < 2 * ROWS_PAD; i += ngw * 64) ROW_TOK[i] = -1;
            }
            PH_END
            PH_BEGIN
            route2(TOKE, TOKG, TOKRS, CNT, CUR, ROW_TOK, ROW_GATE, ROW_RS, TOK_ROW0, (LAS unsigned*)(L + PEXP_OFF), bx, G, tid);
            PH_END
#define ACT0 ((unsigned char*)(ws + WS_BIG))
#define ACT1 ((unsigned char*)(ws + WS_BIG) + (size_t)ROWS_PAD * FFE)
            PH_BEGIN
            {   const int np = moe_panels(CNT, PEXP, tid);
                pg8::MoeGatherOrder S; S.init(np, 2 * FFE / 256, G, bx, XQ, ws + WS_WM + WM_GU, D / 2, WGM_MOEUP); S.pexp = PEXP; S.e_stride = WM_ESTRIDE; S.row_tok = ROW_TOK;
                pg8::EpiSwiglu8<false> E{ACT0, FFE, nullptr};
                pg8::gemm_phase<pg8::EpiSwiglu8<false>, pg8::MoeGatherOrder, true, true>(L, D / 2, S, E, tid PT_ARG); }
            PH_END
            PH_BEGIN
            {   const int np0 = moe_panels(CNT, PEXP, tid);
                {   pg8::MoeOrder S; S.init(np0, D / 256, G, bx, ACT0, ws + WS_WM + WM_D, FFE / 2, WGM_MOEDN); S.pexp = PEXP; S.e_stride = WM_ESTRIDE;
                    pg8::EpiMoeDown0 E{Y0BUF, ROW_GATE};
                    pg8::gemm_phase<pg8::EpiMoeDown0, pg8::MoeOrder, true, true>(L, FFE / 2, S, E, tid PT_ARG); }
                const int np1 = moe_panels(CNT + 8, PEXP, TID_FRESH());
                {   pg8::MoeGatherOrderSkew S; S.init(np1, 2 * FFE / 256, G, bx, XQ, ws + WS_WM + WM_GU, D / 2, WGM_MOEUP); S.pexp = PEXP; S.e_stride = WM_ESTRIDE; S.row_tok = ROW_TOK + ROWS_PAD;
                    S.nheavy = (np0 * 4) % G; S.skip = SKEW_SKIP;
                    pg8::EpiSwiglu8<false> E{ACT1, FFE, nullptr};
                    pg8::gemm_phase<pg8::EpiSwiglu8<false>, pg8::MoeGatherOrderSkew, true, true>(L, D / 2, S, E, TID_FRESH() PT_ARG); } }
            PH_END
            PH_BEGIN
            {   const int np = moe_panels(CNT + 8, PEXP, tid);
                pg8::MoeOrder S; S.init(np, D / 256, G, bx, ACT1, ws + WS_WM + WM_D, FFE / 2, WGM_MOEDN); S.pexp = PEXP; S.e_stride = WM_ESTRIDE;
                pg8::EpiMoeDown1 E{STR, SS, ROW_TOK + ROWS_PAD, ROW_GATE + ROWS_PAD, Y0BUF, TOK_ROW0};
                pg8::gemm_phase<pg8::EpiMoeDown1, pg8::MoeOrder, true, true>(L, FFE / 2, S, E, tid PT_ARG); }
            PH_END
        }
    }
    PH_BEGIN
    {   const float* ssf = SS; const float* gn = args.in[(I_NFIN) + zk_];
        f32x4 gna[2], gnb[2];
#pragma unroll
        for (int gq = 0; gq < 2; ++gq) { gna[gq] = *(const f32x4*)(gn + 8 * (64 * gq + lane)); gnb[gq] = *(const f32x4*)(gn + 8 * (64 * gq + lane) + 4); }
        for (int r0 = gw; r0 < M; r0 += 2 * ngw) {
            float hv[2][2][8]; float rs[2];
#pragma unroll
            for (int q = 0; q < 2; ++q) { const int r = (r0 + q * ngw < M) ? r0 + q * ngw : r0; rs[q] = 1.0f / sqrtf(pg8::part_sum(ssf, r) * (1.0f / 1024.0f) + EPS);
#pragma unroll
                for (int gq = 0; gq < 2; ++gq) pg8::hl_load8(STR + (size_t)r * 4096 + (64 * gq + lane) * 16, hv[q][gq]); }
            asm volatile("s_waitcnt vmcnt(0)" ::: "memory");
#pragma unroll
            for (int q = 0; q < 2; ++q) { const int r = r0 + q * ngw; if (r < M && (q == 0 || r != r0)) { unsigned char* sr = STR + (size_t)r * 4096;
#pragma unroll
                for (int gq = 0; gq < 2; ++gq) { const int g = 64 * gq + lane; const float s = rs[q];
                    *(f32x4*)(sr + g * 32) = (f32x4){hv[q][gq][0] * s * gna[gq].x, hv[q][gq][1] * s * gna[gq].y, hv[q][gq][2] * s * gna[gq].z, hv[q][gq][3] * s * gna[gq].w};
                    *(f32x4*)(sr + g * 32 + 16) = (f32x4){hv[q][gq][4] * s * gnb[gq].x, hv[q][gq][5] * s * gnb[gq].y, hv[q][gq][6] * s * gnb[gq].z, hv[q][gq][7] * s * gnb[gq].w}; } } } } }
    PH_END
#undef PH_BEGIN
#undef PH_END
#if defined(PROBE_SEC)
    if ((int)blockIdx.x == PROBE_WG) { const unsigned long long t1 = __builtin_amdgcn_s_memrealtime(); while (__builtin_amdgcn_s_memrealtime() - t1 < pt_acc * PROBE_MUL) __builtin_amdgcn_s_sleep(8); }
#endif
}

#ifndef MK_PER_PHASE
#define MK_PER_PHASE 0
#endif
constexpr int N_PHASES = 1 + DEPTH * 7 + (DEPTH / 2) * 2 + (DEPTH / 2) * 5 + 1;
extern "C" void kernel_launch(void* const* d_in, const int* in_sizes, int n_in, void* d_out, int out_size, void* d_ws, size_t ws_size, hipStream_t stream) {
    static int grid = 0;
    if (grid == 0) {
        if (n_in != N_IN || in_sizes[0] != M * D || out_size != M * D || ws_size < WS_END) { fprintf(stderr, "kernel_launch: unexpected shapes / workspace (n_in %d, in0 %d, out %d, ws %zu, need %zu); nothing launched\n", n_in, n_in > 0 ? in_sizes[0] : -1, out_size, ws_size, (size_t)WS_END); grid = -1; return; }
        int dev = 0, cus = 0, per_cu = 0;
        if (hipGetDevice(&dev) != hipSuccess || hipDeviceGetAttribute(&cus, hipDeviceAttributeMultiprocessorCount, dev) != hipSuccess) { grid = -1; return; }
        if (hipFuncSetAttribute((const void*)fwd, hipFuncAttributeMaxDynamicSharedMemorySize, LDS_BYTES) != hipSuccess) { fprintf(stderr, "kernel_launch: hipFuncSetAttribute failed\n"); grid = -1; return; }
        if (hipOccupancyMaxActiveBlocksPerMultiprocessor(&per_cu, (const void*)fwd, NWAVES * 64, LDS_BYTES) != hipSuccess || per_cu < 1) fprintf(stderr, "kernel_launch: occupancy query reports %d workgroups per CU\n", per_cu);
        (void)hipGetLastError();
        grid = cus;
        if (grid < 128) { fprintf(stderr, "kernel_launch: %d CUs: this kernel needs at least 128 workgroups; nothing launched\n", grid); grid = -1; return; }
    }
    if (grid < 0) return;
    if (hipMemsetAsync((char*)d_ws + WS_CTL, 0, CTL_ZERO_BYTES, stream) != hipSuccess) { fprintf(stderr, "kernel_launch: memset failed\n"); return; }
    Args a{};
    for (int i = 0; i < N_IN; ++i) a.in[i] = (const float*)d_in[i];
    a.out = (float*)d_out; a.ws = (unsigned char*)d_ws;
#if MK_PER_PHASE
    for (int p = 0; p < N_PHASES; ++p) { a.ph_lo = p; a.ph_hi = p + 1; hipLaunchKernelGGL(fwd, dim3(grid), dim3(NWAVES * 64), LDS_BYTES, stream, a); }
#else
    a.ph_lo = 0; a.ph_hi = N_PHASES;
    hipLaunchKernelGGL(fwd, dim3(grid), dim3(NWAVES * 64), LDS_BYTES, stream, a);
#endif
#ifdef PROBE_LIST
    { const int plist[] = PROBE_LIST; a.flags = PROBE_FLAGS; for (unsigned i = 0; i < sizeof(plist) / sizeof(int); ++i) { a.ph_lo = plist[i]; a.ph_hi = plist[i] + 1; hipLaunchKernelGGL(fwd, dim3(grid), dim3(NWAVES * 64), LDS_BYTES, stream, a); } }
#endif
    const hipError_t le = hipPeekAtLastError();
    if (le != hipSuccess) fprintf(stderr, "kernel_launch: launch failed: %s\n", hipGetErrorName(le));
}
```
